# Optimizing an MI355X kernel written in HIP

```python
import math
import jax, jax.numpy as jnp
from jax import lax
import numpy as np

D_MODEL = 1024
BATCH = 2
SEQ = 16384
DEPTH = 4

ML_HEADS = 4
ML_HEAD_DIM = 128
ML_WIDTH = ML_HEADS * ML_HEAD_DIM
ML_CHUNK = 64
CONV_WIDTH = 4
AT_HEADS = 8
AT_HEAD_DIM = 64
AT_WIDTH = AT_HEADS * AT_HEAD_DIM
MIX_WIDTH = ML_WIDTH + AT_WIDTH
MOBA_BLOCK = 256
MOBA_TOPK = 3
MOBA_QCHUNK = 64
EPS = 1e-6
PROJ_SIZES = (2 * ML_WIDTH, ML_WIDTH, ML_WIDTH, ML_WIDTH, ML_HEADS, ML_HEADS, AT_WIDTH, AT_WIDTH, AT_WIDTH, AT_WIDTH)
PROJ_WIDTH = 4 * ML_WIDTH + ML_WIDTH + 2 * ML_HEADS + 4 * AT_WIDTH

kernel_name = 'hybrid_mlstm_moba_alibi'


def _split_points():
    pts, acc = [], 0
    for s in PROJ_SIZES[:-1]:
        acc += s
        pts.append(acc)
    return pts


def _rmsnorm(x, w):
    xf = x.astype(jnp.float32)
    return xf * lax.rsqrt(jnp.mean(xf * xf, axis=-1, keepdims=True) + EPS) * w.astype(jnp.float32)


def _causal_conv(x, w, b):
    K, S = w.shape[0], x.shape[1]
    xp = jnp.pad(x, ((0, 0), (K - 1, 0), (0, 0)))
    return b + sum(xp[:, k:k + S] * w[k] for k in range(K))


def _mlstm_chunkwise(q, k, v, i_pre, f_pre):
    B, S, H, Dh = q.shape
    L = ML_CHUNK
    nc = S // L

    def heads_chunks(t):
        t = t.reshape(B, nc, L, H, *t.shape[3:])
        return jnp.moveaxis(t, 3, 1)

    q = heads_chunks(q) * Dh ** -0.5
    k = heads_chunks(k)
    v = heads_chunks(v)
    ig = heads_chunks(i_pre)
    b = jnp.cumsum(jax.nn.log_sigmoid(heads_chunks(f_pre)), axis=-1)
    b_last = b[..., -1]
    a = b_last[..., None] - b + ig
    m_loc = jnp.max(a, axis=-1)
    w_loc = jnp.exp(a - m_loc[..., None])
    c_loc = jnp.einsum('bhcl,bhcld,bhcle->bhcde', w_loc, k, v)
    n_loc = jnp.einsum('bhcl,bhcld->bhcd', w_loc, k)

    def step(carry, xs):
        c, n, m = carry
        c_l, n_l, m_l, bl = xs
        m_new = jnp.maximum(bl + m, m_l)
        s_prev = jnp.exp(bl + m - m_new)
        s_loc = jnp.exp(m_l - m_new)
        c_new = s_prev[..., None, None] * c + s_loc[..., None, None] * c_l
        n_new = s_prev[..., None] * n + s_loc[..., None] * n_l
        return (c_new, n_new, m_new), (c, n, m)

    init = (jnp.zeros((B, H, Dh, Dh), q.dtype), jnp.zeros((B, H, Dh), q.dtype), jnp.zeros((B, H), q.dtype))
    xs = (jnp.moveaxis(c_loc, 2, 0), jnp.moveaxis(n_loc, 2, 0), jnp.moveaxis(m_loc, 2, 0), jnp.moveaxis(b_last, 2, 0))
    _, (c_prev, n_prev, m_prev) = lax.scan(step, init, xs)
    c_prev = jnp.moveaxis(c_prev, 0, 2)
    n_prev = jnp.moveaxis(n_prev, 0, 2)
    m_prev = jnp.moveaxis(m_prev, 0, 2)

    causal = jnp.tril(jnp.ones((L, L), dtype=bool))
    d = jnp.where(causal, b[..., :, None] - b[..., None, :] + ig[..., None, :], -jnp.inf)
    g = b + m_prev[..., None]
    m_t = jnp.maximum(g, jnp.max(d, axis=-1))
    w_intra = jnp.exp(d - m_t[..., None])
    s_inter = jnp.exp(g - m_t)
    qk = jnp.einsum('bhctd,bhcsd->bhcts', q, k) * w_intra
    num = jnp.einsum('bhcts,bhcse->bhcte', qk, v) + s_inter[..., None] * jnp.einsum('bhctd,bhcde->bhcte', q, c_prev)
    den = jnp.sum(qk, axis=-1) + s_inter * jnp.einsum('bhctd,bhcd->bhct', q, n_prev)
    h = num / jnp.maximum(jnp.abs(den), jnp.exp(-m_t))[..., None]
    return jnp.moveaxis(h, 1, 3).reshape(B, S, H, Dh)


def _moba_attention(q, k, v, slopes):
    B, S, H, Dh = q.shape
    nb = -(-S // MOBA_BLOCK)
    s_pad = nb * MOBA_BLOCK
    pad = ((0, 0), (0, s_pad - S), (0, 0), (0, 0))
    q = jnp.pad(q, pad).transpose(0, 2, 1, 3)
    k = jnp.pad(k, pad).transpose(0, 2, 1, 3)
    v = jnp.pad(v, pad).transpose(0, 2, 1, 3)
    scale = Dh ** -0.5
    kb = k.reshape(B, H, nb, MOBA_BLOCK, Dh)
    vb = v.reshape(B, H, nb, MOBA_BLOCK, Dh)
    k_mean = jnp.mean(kb, axis=3)
    pos = jnp.arange(s_pad)
    gate = jnp.einsum('bhtd,bhnd->bhtn', q, k_mean)
    past = jnp.arange(nb)[None, :] < (pos // MOBA_BLOCK)[:, None]
    gate = jnp.where(past, gate, -jnp.inf)
    topk = min(MOBA_TOPK, nb)
    g_val, sel = lax.top_k(gate, topk)
    valid = jnp.isfinite(g_val)
    nq = s_pad // MOBA_QCHUNK

    def to_chunks(t):
        return jnp.moveaxis(t.reshape(B, H, nq, MOBA_QCHUNK, *t.shape[3:]), 2, 0)

    bi = jnp.arange(B)[:, None, None, None]
    hi = jnp.arange(H)[None, :, None, None]
    offs = jnp.arange(MOBA_BLOCK)

    def one_chunk(args):
        q_c, sel_c, valid_c, ci = args
        q_pos = ci * MOBA_QCHUNK + jnp.arange(MOBA_QCHUNK)
        n_own = (ci * MOBA_QCHUNK) // MOBA_BLOCK
        k_own = lax.dynamic_index_in_dim(kb, n_own, axis=2, keepdims=False)
        v_own = lax.dynamic_index_in_dim(vb, n_own, axis=2, keepdims=False)
        dist_own = q_pos[:, None] - (n_own * MOBA_BLOCK + offs)[None, :]
        s_own = jnp.einsum('bhqd,bhsd->bhqs', q_c, k_own) * scale - slopes[:, None, None] * dist_own
        s_own = jnp.where(dist_own >= 0, s_own, -jnp.inf)
        k_sel = kb[bi, hi, sel_c]
        v_sel = vb[bi, hi, sel_c]
        dist_sel = q_pos[:, None, None] - (sel_c[..., None] * MOBA_BLOCK + offs)
        s_sel = jnp.einsum('bhqd,bhqksd->bhqks', q_c, k_sel) * scale - slopes[:, None, None, None] * dist_sel
        s_sel = jnp.where(valid_c[..., None], s_sel, -jnp.inf)
        s_all = jnp.concatenate([s_sel.reshape(B, H, MOBA_QCHUNK, topk * MOBA_BLOCK), s_own], axis=-1)
        p = jax.nn.softmax(s_all, axis=-1)
        p_sel = p[..., :topk * MOBA_BLOCK].reshape(B, H, MOBA_QCHUNK, topk, MOBA_BLOCK)
        p_own = p[..., topk * MOBA_BLOCK:]
        return jnp.einsum('bhqks,bhqksd->bhqd', p_sel, v_sel) + jnp.einsum('bhqs,bhsd->bhqd', p_own, v_own)

    out = lax.map(one_chunk, (to_chunks(q), to_chunks(sel), to_chunks(valid), jnp.arange(nq)))
    out = jnp.moveaxis(out, 0, 2).reshape(B, H, s_pad, Dh)[:, :, :S]
    return out.transpose(0, 2, 1, 3)


def _layer(x, norm_w, w_in, b_igate, b_fgate, conv_w, conv_b, mlstm_norm_w, q_norm_w, k_norm_w, w_out, slopes):
    B, S, _ = x.shape
    h = _rmsnorm(x, norm_w).astype(x.dtype)
    proj = (h @ w_in).astype(jnp.float32)
    ml_qk, ml_v, ml_o, ml_z, ml_i, ml_f, at_q, at_k, at_v, at_z = jnp.split(proj, _split_points(), axis=-1)

    ml_qk = jax.nn.silu(_causal_conv(ml_qk, conv_w.astype(jnp.float32), conv_b.astype(jnp.float32)))
    ml_q, ml_k = jnp.split(ml_qk, 2, axis=-1)
    hs = (B, S, ML_HEADS, ML_HEAD_DIM)
    h_ml = _mlstm_chunkwise(ml_q.reshape(hs), ml_k.reshape(hs), ml_v.reshape(hs),
                            ml_i + b_igate.astype(jnp.float32), ml_f + b_fgate.astype(jnp.float32))
    h_ml = jax.nn.sigmoid(ml_o).reshape(hs) * h_ml
    h_ml = _rmsnorm(h_ml, mlstm_norm_w.reshape(ML_HEADS, ML_HEAD_DIM))
    y_ml = h_ml.reshape(B, S, ML_WIDTH) * jax.nn.silu(ml_z)

    ha = (B, S, AT_HEADS, AT_HEAD_DIM)
    q = _rmsnorm(at_q.reshape(ha), q_norm_w)
    k = _rmsnorm(at_k.reshape(ha), k_norm_w)
    o_at = _moba_attention(q, k, at_v.reshape(ha), slopes)
    y_at = o_at.reshape(B, S, AT_WIDTH) * jax.nn.silu(at_z)

    y = jnp.concatenate([y_ml, y_at], axis=-1).astype(x.dtype) @ w_out
    return x + y


def setup_inputs(seed: int = 0) -> dict:
    key = jax.random.key(seed)
    ks = jax.random.split(key, 12)
    f32 = jnp.float32
    x = jax.random.normal(ks[0], (BATCH, SEQ, D_MODEL), f32)
    norm_w = 1.0 + 0.05 * jax.random.normal(ks[1], (DEPTH, D_MODEL), f32)
    w_in = jax.random.normal(ks[2], (DEPTH, D_MODEL, PROJ_WIDTH), f32) * D_MODEL ** -0.5
    b_igate = 0.1 * jax.random.normal(ks[3], (DEPTH, ML_HEADS), f32)
    b_fgate = jnp.linspace(3.0, 6.0, ML_HEADS, dtype=f32)[None, :] + 0.1 * jax.random.normal(ks[4], (DEPTH, ML_HEADS), f32)
    conv_w = jax.random.normal(ks[5], (DEPTH, CONV_WIDTH, 2 * ML_WIDTH), f32) * CONV_WIDTH ** -0.5
    conv_b = 0.02 * jax.random.normal(ks[6], (DEPTH, 2 * ML_WIDTH), f32)
    mlstm_norm_w = 1.0 + 0.05 * jax.random.normal(ks[7], (DEPTH, ML_WIDTH), f32)
    q_norm_w = 1.0 + 0.05 * jax.random.normal(ks[8], (DEPTH, AT_HEAD_DIM), f32)
    k_norm_w = 1.0 + 0.05 * jax.random.normal(ks[9], (DEPTH, AT_HEAD_DIM), f32)
    w_out = jax.random.normal(ks[10], (DEPTH, MIX_WIDTH, D_MODEL), f32) * MIX_WIDTH ** -0.5
    return {'x': x, 'norm_w': norm_w, 'w_in': w_in, 'b_igate': b_igate, 'b_fgate': b_fgate,
            'conv_w': conv_w, 'conv_b': conv_b, 'mlstm_norm_w': mlstm_norm_w,
            'q_norm_w': q_norm_w, 'k_norm_w': k_norm_w, 'w_out': w_out}


def reference(x, norm_w, w_in, b_igate, b_fgate, conv_w, conv_b, mlstm_norm_w, q_norm_w, k_norm_w, w_out):
    slopes = 2.0 ** (-8.0 * (jnp.arange(AT_HEADS, dtype=jnp.float32) + 1.0) / AT_HEADS)
    for l in range(DEPTH):
        x = _layer(x, norm_w[l], w_in[l], b_igate[l], b_fgate[l], conv_w[l], conv_b[l],
                   mlstm_norm_w[l], q_norm_w[l], k_norm_w[l], w_out[l], slopes)
    return x
```

```cpp
#include <hip/hip_runtime.h>
#include <cstdio>
#include <cstdint>
namespace pg8 {
#define PG8_LAS __attribute__((address_space(3)))
typedef unsigned short bf16_t;
typedef short bf16x8 __attribute__((ext_vector_type(8)));
typedef float f32x4 __attribute__((ext_vector_type(4)));
typedef unsigned u32x4 __attribute__((ext_vector_type(4)));
constexpr int BM = 256, BK = 64, HALF = 128, HTB = HALF * BK * 2  , STAGE_BYTES = 8 * HTB, NXCD = 8, WGM = 8;

__host__ __device__ __forceinline__ int lds_byte(int r, int c) { const int st = (r >> 4) * 2 + (c >> 5), rr = r & 15, cc = c & 31, ob = rr * 64 + cc * 2; return st * 1024 + (ob ^ (((ob >> 9) & 1) << 5)); }
__host__ __device__ __forceinline__ void stage_rc(int b, int& R, int& C) { const int st = b / 1024, sb = b % 1024, swz = sb ^ (((sb >> 9) & 1) << 5); R = (st >> 1) * 16 + swz / 64; C = (st & 1) * 32 + (swz % 64) / 2; }
__host__ __device__ __forceinline__ int perm32(int rho) { const int n = rho >> 4, i = rho & 15; return 8 * (i >> 2) + 4 * n + (i & 3); }

struct Unit { int pm, pn; };
struct Gemm { const bf16_t* A; const bf16_t* Bt; int M, N, K; };

struct StaticOrder {
    int nM, nN, nwg, G, c;
    __host__ __device__ void init(int M, int N, int G_, int c_) { nM = M / BM; nN = N / BM; nwg = nM * nN; G = G_; c = c_; }
    __host__ __device__ bool next(int i, Unit& u) const {
        const long L = (long)i * G + c; if (L >= nwg) return false;
        int wgid = (int)L; { const int q = nwg / NXCD, r = nwg % NXCD, xcd = wgid % NXCD, off = wgid / NXCD; wgid = (xcd < r ? xcd * (q + 1) : r * (q + 1) + (xcd - r) * q) + off; }
        const int nig = WGM * nN, gid = wgid / nig, fm = gid * WGM, gsz = (nM - fm) < WGM ? (nM - fm) : WGM;
        u.pm = fm + ((wgid % nig) % gsz); u.pn = (wgid % nig) / gsz; return true;
    }
    __device__ __forceinline__ void a_ready(const Unit&) const {}
    __device__ __forceinline__ void done(const Unit&) const {}
};

__device__ __forceinline__ unsigned cvt_pk_bf16(float lo, float hi) { unsigned r; asm volatile("v_cvt_pk_bf16_f32 %0, %1, %2" : "=v"(r) : "v"(lo), "v"(hi)); return r; }
typedef float f32x2 __attribute__((ext_vector_type(2)));
__device__ __forceinline__ float sigmoid_f(float v) { return 1.0f / (1.0f + __expf(-v)); }
struct EpiProj {
    static constexpr bool PERM = true, AFTER_DRAIN = false;
    bf16_t* O; int ldc; unsigned long long acts;
    __device__ __forceinline__ void operator()(const f32x4 (&acc)[2][2][4][2], const Unit& u, int wr, int wc, int fr, int fq) const {
        const int row0 = u.pm * BM + wr * 64 + fr; const int col0 = u.pn * BM + wc * 32 + 8 * fq;
        const int act = (int)((acts >> (2 * u.pn)) & 3ull);
#pragma unroll
        for (int ai = 0; ai < 2; ++ai)
#pragma unroll
            for (int m = 0; m < 4; ++m) { bf16_t* rowp = O + (size_t)(row0 + ai * HALF + m * 16) * ldc + col0;
#pragma unroll
                for (int bj = 0; bj < 2; ++bj) { f32x4 v0 = acc[ai][bj][m][0], v1 = acc[ai][bj][m][1];
                    if (act != 0) {
#pragma unroll
                        for (int i = 0; i < 4; ++i) { const float s0 = sigmoid_f(v0[i]), s1 = sigmoid_f(v1[i]); v0[i] = (act == 1) ? s0 : v0[i] * s0; v1[i] = (act == 1) ? s1 : v1[i] * s1; }
                    }
                    u32x4 w; w.x = cvt_pk_bf16(v0[0], v0[1]); w.y = cvt_pk_bf16(v0[2], v0[3]); w.z = cvt_pk_bf16(v1[0], v1[1]); w.w = cvt_pk_bf16(v1[2], v1[3]);
                    *(u32x4*)(rowp + bj * HALF) = w; } }
    }
};
struct EpiRes {
    static constexpr bool PERM = false, AFTER_DRAIN = false;
    const float* base; float* out; int ldc;
    __device__ __forceinline__ void operator()(const f32x4 (&acc)[2][2][4][2], const Unit& u, int wr, int wc, int fr, int fq) const {
        const int col0 = u.pn * BM + wc * 32 + 4 * fq;
#pragma unroll
        for (int ai = 0; ai < 2; ++ai)
#pragma unroll
            for (int m = 0; m < 4; ++m) { const size_t off = (size_t)(u.pm * BM + ai * HALF + wr * 64 + m * 16 + fr) * ldc + col0;
#pragma unroll
                for (int bj = 0; bj < 2; ++bj)
#pragma unroll
                    for (int n = 0; n < 2; ++n) { const f32x4 bs = *(const f32x4*)(base + off + bj * HALF + n * 16); *(f32x4*)(out + off + bj * HALF + n * 16) = bs + acc[ai][bj][m][n]; } }
    }
};
template <class Epi, class Sched, bool ALIGN_EPI = false, bool SP2 = false>
__device__ __forceinline__ void gemm_phase(PG8_LAS unsigned char* lds, const Gemm g, const Sched& S, const Epi& E) {
    int tid_l = threadIdx.x; asm volatile("" : "+v"(tid_l));
    const int tid = tid_l, wid = __builtin_amdgcn_readfirstlane(tid >> 6), lane = tid & 63, wr = wid >> 2, wc = wid & 3, fr = lane & 15, fq = lane >> 4;
    const int K = g.K, nt = K / BK;
    unsigned voffA[2], voffB[2];
#pragma unroll
    for (int i = 0; i < 2; ++i) { int R, C; stage_rc(tid * 16 + i * 8192, R, C); const int Rb = Epi::PERM ? ((R & ~31) + perm32(R & 31)) : R;
        voffA[i] = (unsigned)(R * K + C) * 2u; voffB[i] = (unsigned)(Rb * K + C) * 2u; }
    const size_t kstep = (size_t)(BK * 2);
    const size_t hstep = (size_t)HALF * K * 2;
    const size_t tstep = 2 * hstep;
    const unsigned ldsw = (unsigned)wid * 1024u;
    const int aoff = lds_byte(wr * 64 + fr, fq * 8), boff = lds_byte(wc * 32 + fr, fq * 8);
#define PG8_SA(b, h) (((b) * 2 + (h)) * HTB)
#define PG8_SB(b, h) ((4 + (b) * 2 + (h)) * HTB)
#define PG8_STAGE(bufoff, gbase, voff) do { _Pragma("unroll") for (int _i = 0; _i < 2; ++_i) \
        __builtin_amdgcn_global_load_lds((const unsigned*)((const char*)(gbase) + (voff)[_i]), (PG8_LAS unsigned*)(lds + (bufoff) + ldsw + _i * 8192), 16, 0, 0); } while (0)
#define PG8_LDA(dst, b, h) do { _Pragma("unroll") for (int m = 0; m < 4; ++m) _Pragma("unroll") for (int k = 0; k < 2; ++k) dst[m][k] = *(const PG8_LAS bf16x8*)(lds + PG8_SA(b, h) + aoff + m * 2048 + k * 1024); } while (0)
#define PG8_LDB(dst, b, h) do { _Pragma("unroll") for (int n = 0; n < 2; ++n) _Pragma("unroll") for (int k = 0; k < 2; ++k) dst[n][k] = *(const PG8_LAS bf16x8*)(lds + PG8_SB(b, h) + boff + n * 2048 + k * 1024); } while (0)
#define PG8_MMA(ai, bj, At, Bt) do { __builtin_amdgcn_s_setprio(1); _Pragma("unroll") for (int m = 0; m < 4; ++m) _Pragma("unroll") for (int n = 0; n < 2; ++n) _Pragma("unroll") for (int k = 0; k < 2; ++k) \
        acc[ai][bj][m][n] = __builtin_amdgcn_mfma_f32_16x16x32_bf16(Bt[n][k], At[m][k], acc[ai][bj][m][n], 0, 0, 0); __builtin_amdgcn_s_setprio(0); } while (0)
#define PG8_WAIT_V(n) asm volatile("s_waitcnt vmcnt(" #n ")" ::: "memory")
#define PG8_WAIT_L(n) asm volatile("s_waitcnt lgkmcnt(" #n ")" ::: "memory")
#define PG8_BAR __builtin_amdgcn_s_barrier()
#define PG8_SCHED __builtin_amdgcn_sched_barrier(0)
    Unit cur, nxt; int ui = 0;
    if (!S.next(0, cur)) return;
    f32x4 acc[2][2][4][2];
#pragma unroll
    for (int a = 0; a < 2; ++a)
#pragma unroll
        for (int b = 0; b < 2; ++b)
#pragma unroll
            for (int m = 0; m < 4; ++m)
#pragma unroll
                for (int n = 0; n < 2; ++n) acc[a][b][m][n] = (f32x4){0.f, 0.f, 0.f, 0.f};
    bf16x8 At[4][2], B0[2][2], B1[2][2];
    const char* cA = (const char*)g.A + (size_t)cur.pm * tstep; const char* cB = (const char*)g.Bt + (size_t)cur.pn * tstep;
    S.a_ready(cur);
    if constexpr (SP2) {
        PG8_STAGE(PG8_SB(0, 0), cB, voffB); PG8_STAGE(PG8_SB(0, 1), cB + hstep, voffB); PG8_STAGE(PG8_SA(0, 0), cA, voffA); PG8_STAGE(PG8_SA(0, 1), cA + hstep, voffA);
        if (wr == 1) PG8_BAR;
        PG8_WAIT_V(2); PG8_BAR;
        PG8_STAGE(PG8_SB(1, 0), cB + kstep, voffB); PG8_STAGE(PG8_SA(1, 0), cA + kstep, voffA); PG8_STAGE(PG8_SB(1, 1), cB + hstep + kstep, voffB);
        PG8_WAIT_V(6); PG8_BAR;
    } else {
        PG8_STAGE(PG8_SB(0, 0), cB, voffB); PG8_STAGE(PG8_SA(0, 0), cA, voffA); PG8_STAGE(PG8_SB(0, 1), cB + hstep, voffB); PG8_STAGE(PG8_SA(0, 1), cA + hstep, voffA);
        if (wr == 1) PG8_BAR;
        PG8_WAIT_V(4); PG8_BAR;
        PG8_STAGE(PG8_SB(1, 0), cB + kstep, voffB); PG8_STAGE(PG8_SA(1, 0), cA + kstep, voffA); PG8_STAGE(PG8_SB(1, 1), cB + hstep + kstep, voffB);
        PG8_WAIT_V(6); PG8_BAR;
    }
    for (;;) {
        const bool has_next = S.next(ui + 1, nxt);
        const char* nA = has_next ? (const char*)g.A + (size_t)nxt.pm * tstep : cA; const char* nB = has_next ? (const char*)g.Bt + (size_t)nxt.pn * tstep : cB;
        for (int t = 0; t < nt; t += 2) {
            const bool last = (t == nt - 2);
            const char* a1 = cA + (size_t)(t + 1) * kstep;
            const char* a2 = last ? nA : cA + (size_t)(t + 2) * kstep; const char* b2 = last ? nB : cB + (size_t)(t + 2) * kstep;
            const char* a3 = a2 + kstep; const char* b3 = b2 + kstep;
            if (last && has_next) S.a_ready(nxt);
            if constexpr (SP2) {
            PG8_LDB(B0, 0, 0); PG8_LDB(B1, 0, 1); PG8_SCHED; PG8_LDA(At, 0, 0); PG8_STAGE(PG8_SA(1, 1), a1 + hstep, voffA);
            PG8_WAIT_V(8); PG8_WAIT_L(0); PG8_BAR; PG8_MMA(0, 0, At, B0); PG8_MMA(0, 1, At, B1); PG8_BAR; PG8_SCHED;
            PG8_LDA(At, 0, 1); PG8_STAGE(PG8_SB(0, 0), b2, voffB); PG8_STAGE(PG8_SB(0, 1), b2 + hstep, voffB); PG8_STAGE(PG8_SA(0, 0), a2, voffA);
            PG8_WAIT_V(8); PG8_WAIT_L(0); PG8_BAR; PG8_MMA(1, 0, At, B0); PG8_MMA(1, 1, At, B1); PG8_BAR; PG8_SCHED;
            PG8_LDB(B0, 1, 0); PG8_LDB(B1, 1, 1); PG8_SCHED; PG8_LDA(At, 1, 0); PG8_STAGE(PG8_SA(0, 1), a2 + hstep, voffA);
            PG8_WAIT_V(8); PG8_WAIT_L(0); PG8_BAR; PG8_MMA(0, 0, At, B0); PG8_MMA(0, 1, At, B1); PG8_BAR; PG8_SCHED;
            PG8_LDA(At, 1, 1); PG8_STAGE(PG8_SB(1, 0), b3, voffB); PG8_STAGE(PG8_SB(1, 1), b3 + hstep, voffB); PG8_STAGE(PG8_SA(1, 0), a3, voffA);
            PG8_WAIT_V(8); PG8_WAIT_L(0); PG8_BAR; PG8_MMA(1, 0, At, B0); PG8_MMA(1, 1, At, B1); PG8_BAR; PG8_SCHED;
            } else {
            PG8_LDB(B0, 0, 0); PG8_SCHED; PG8_LDA(At, 0, 0); PG8_STAGE(PG8_SA(1, 1), a1 + hstep, voffA);
            PG8_WAIT_L(8); PG8_BAR; PG8_WAIT_L(0); PG8_MMA(0, 0, At, B0); PG8_BAR; PG8_SCHED;
            PG8_LDB(B1, 0, 1); PG8_STAGE(PG8_SB(0, 0), b2, voffB);
            PG8_BAR; PG8_WAIT_L(0); PG8_MMA(0, 1, At, B1); PG8_BAR;
            PG8_LDA(At, 0, 1); PG8_STAGE(PG8_SA(0, 0), a2, voffA);
            PG8_BAR; PG8_WAIT_L(0); PG8_MMA(1, 0, At, B0); PG8_BAR; PG8_SCHED;
            PG8_STAGE(PG8_SB(0, 1), b2 + hstep, voffB);
            PG8_WAIT_V(6); PG8_BAR; PG8_MMA(1, 1, At, B1); PG8_BAR;
            PG8_LDB(B0, 1, 0); PG8_SCHED; PG8_LDA(At, 1, 0); PG8_STAGE(PG8_SA(0, 1), a2 + hstep, voffA);
            PG8_WAIT_L(8); PG8_BAR; PG8_WAIT_L(0); PG8_MMA(0, 0, At, B0); PG8_BAR; PG8_SCHED;
            PG8_LDB(B1, 1, 1); PG8_STAGE(PG8_SB(1, 0), b3, voffB);
            PG8_BAR; PG8_WAIT_L(0); PG8_MMA(0, 1, At, B1); PG8_BAR;
            PG8_LDA(At, 1, 1); PG8_STAGE(PG8_SA(1, 0), a3, voffA);
            PG8_BAR; PG8_WAIT_L(0); PG8_MMA(1, 0, At, B0); PG8_BAR; PG8_SCHED;
            PG8_STAGE(PG8_SB(1, 1), b3 + hstep, voffB);
            PG8_WAIT_V(6); PG8_BAR; PG8_MMA(1, 1, At, B1); PG8_BAR;
            }
        }
        if constexpr (ALIGN_EPI) { if (wr == 0) PG8_BAR; }
        if constexpr (!Epi::AFTER_DRAIN) { E(acc, cur, wr, wc, fr, fq); S.done(cur); }
        if (!has_next) break;
#pragma unroll
        for (int a = 0; a < 2; ++a)
#pragma unroll
            for (int b = 0; b < 2; ++b)
#pragma unroll
                for (int m = 0; m < 4; ++m)
#pragma unroll
                    for (int n = 0; n < 2; ++n) acc[a][b][m][n] = (f32x4){0.f, 0.f, 0.f, 0.f};
        cur = nxt; cA = nA; cB = nB; ++ui;
        if constexpr (ALIGN_EPI) { if (wr == 1) PG8_BAR; }
    }
    PG8_WAIT_V(0);
    if constexpr (!ALIGN_EPI) { if (wr == 0) PG8_BAR; }
    PG8_BAR;
    if constexpr (Epi::AFTER_DRAIN) { E.fused(acc, cur, wr, wc, fr, fq, lds, wid, lane); S.done(cur); }
#undef PG8_SA
#undef PG8_SB
#undef PG8_STAGE
#undef PG8_LDA
#undef PG8_LDB
#undef PG8_MMA
#undef PG8_WAIT_V
#undef PG8_WAIT_L
#undef PG8_BAR
#undef PG8_SCHED
}
}
#define GAS __attribute__((address_space(1)))
#define LAS __attribute__((address_space(3)))
typedef unsigned short bf16;
typedef unsigned v4u __attribute__((ext_vector_type(4)));
typedef float f32x4 __attribute__((ext_vector_type(4)));
typedef short bf16x8 __attribute__((ext_vector_type(8)));
typedef GAS unsigned gu32;
typedef GAS unsigned long long gu64;
#define RLX_AGENT __ATOMIC_RELAXED, __HIP_MEMORY_SCOPE_AGENT
#define LDS_WAIT() asm volatile("s_waitcnt lgkmcnt(0)" ::: "memory")
#define VM_WAIT() asm volatile("s_waitcnt vmcnt(0)" ::: "memory")
__device__ __forceinline__ unsigned long long rt() { return __builtin_amdgcn_s_memrealtime(); }
__device__ __forceinline__ unsigned f2bf(float f) { unsigned u = __builtin_bit_cast(unsigned, f); return (u + 0x7fffu + ((u >> 16) & 1u)) >> 16; }
__device__ __forceinline__ unsigned pk2(float lo, float hi) { return f2bf(lo) | (f2bf(hi) << 16); }

#define XB_TMO      128
#define XB_XCNT(j)  (256  + 64 * (j))
#define XB_XSUB(j)  (1280 + 64 * (j))
#define XB_XGEN(j)  (2304 + 64 * (j))
#define XB_TOP      3328
#define XB_TOPGEN   3392
#define XCD_BAR_WORDS 3456
#define XB_SPIN_CAP (1u << 18)

__device__ __forceinline__ unsigned xb_ld(unsigned* p)              { return __hip_atomic_load(p, __ATOMIC_RELAXED, __HIP_MEMORY_SCOPE_AGENT); }
__device__ __forceinline__ unsigned xb_add(unsigned* p, unsigned v) { return __hip_atomic_fetch_add(p, v, __ATOMIC_RELAXED, __HIP_MEMORY_SCOPE_AGENT); }
__device__ __forceinline__ unsigned xb_xcc_id() { return (unsigned)__builtin_amdgcn_s_getreg((3 << 11) | 20) & 0xFu; }
#define XB_SPIN(cond, bar) do { unsigned _sp = 0; while (cond) { __builtin_amdgcn_s_sleep(1); \
    if ((++_sp & 255u) == 0u) { if (xb_ld(&(bar)[XB_TMO])) break; if (_sp > XB_SPIN_CAP) { atomicAdd(&(bar)[XB_TMO], 1u); break; } } } } while (0)

struct XcdBarrier {
    unsigned* bar; unsigned x;
    volatile LAS unsigned* st;
};

__device__ __forceinline__ XcdBarrier xcd_barrier_post(unsigned* bar, volatile LAS unsigned* st) {
    XcdBarrier b; b.bar = bar; b.x = xb_xcc_id(); b.st = st;
    if (threadIdx.x == 0) (void)xb_add(&bar[XB_XCNT(b.x)], 1u);
    return b;
}
__device__ __forceinline__ void xcd_barrier_complete(unsigned* bar, unsigned x, unsigned& nloc, unsigned& nx) {
    const unsigned G = gridDim.x * gridDim.y * gridDim.z;
    unsigned sum, cnt, mine, sp = 0u;
    for (;;) {
        sum = 0u; cnt = 0u; mine = 0u;
#pragma unroll
        for (unsigned j = 0; j < 16; ++j) { const unsigned c = xb_ld(&bar[XB_XCNT(j)]); sum += c; cnt += (c > 0u) ? 1u : 0u; mine = (j == x) ? c : mine; }
        if (sum == G) break;
        __builtin_amdgcn_s_sleep(1);
        if ((++sp & 255u) == 0u) { if (xb_ld(&bar[XB_TMO])) break; if (sp > XB_SPIN_CAP) { atomicAdd(&bar[XB_TMO], 1u); break; } }
    }
    nloc = mine > 0u ? mine : 1u; nx = cnt > 0u ? cnt : 1u;
}

__device__ __forceinline__ void xcd_barrier(const XcdBarrier& b) {
    asm volatile("s_waitcnt vmcnt(0)" ::: "memory");
    __syncthreads();
    if (threadIdx.x == 0) {
        unsigned* bar = b.bar;
        __builtin_amdgcn_s_waitcnt(0);
        unsigned nloc = b.st[0], nx = b.st[1];
        if (nloc == 0u) { xcd_barrier_complete(bar, b.x, nloc, nx); b.st[0] = nloc; b.st[1] = nx; }
        const unsigned old = xb_add(&bar[XB_XSUB(b.x)], 1u);
        const unsigned gen = old / nloc;
        if (old + 1u == (gen + 1u) * nloc) {
            __builtin_amdgcn_fence(__ATOMIC_RELEASE, "agent");
            asm volatile("s_waitcnt vmcnt(0)" ::: "memory");
            const unsigned og = xb_add(&bar[XB_TOP], 1u);
            const unsigned tg = og / nx;
            if (og + 1u == (tg + 1u) * nx) xb_add(&bar[XB_TOPGEN], 1u);
            else XB_SPIN(xb_ld(&bar[XB_TOPGEN]) == tg, bar);
            __builtin_amdgcn_fence(__ATOMIC_ACQUIRE, "agent");
            xb_add(&bar[XB_XGEN(b.x)], 1u);
            asm volatile("s_waitcnt vmcnt(0)" ::: "memory");
        } else {
            XB_SPIN(xb_ld(&bar[XB_XGEN(b.x)]) == gen, bar);
            __builtin_amdgcn_fence(__ATOMIC_ACQUIRE, "agent");
            asm volatile("s_waitcnt vmcnt(0)" ::: "memory");
        }
    }
    __syncthreads();
}
constexpr int NB = 2, SEQ = 16384, NTOK = NB * SEQ, DM = 1024, NLAYER = 4;
constexpr int PROJW = 4616, PW = 4608;
constexpr int C_MLQK = 0, C_MLV = 1024, C_MLO = 1536, C_MLZ = 2048, C_ATQ = 2560, C_ATK = 3072, C_ATV = 3584, C_ATZ = 4096;
constexpr int SC = 256, NSC = SEQ / SC;
constexpr int NBLK = SEQ / 256;
constexpr float EPS = 1e-6f;
constexpr int NPH = 7;
constexpr int NGP = 1 + NLAYER * NPH;

constexpr size_t MiB = 1u << 20;
constexpr size_t OFF_CTL = 0, CTL_BYTES = 1 * MiB;
constexpr size_t OFF_WIN = 1 * MiB;
constexpr size_t OFF_WOUT = 37 * MiB;
constexpr size_t OFF_XN = 45 * MiB;
constexpr size_t OFF_GATES = 109 * MiB;
constexpr size_t OFF_PROJ = 110 * MiB;
constexpr size_t OFF_Y = 398 * MiB;
constexpr size_t OFF_CT = 462 * MiB;
constexpr size_t OFF_NL = 494 * MiB;
constexpr size_t OFF_KMEAN = 495 * MiB;
constexpr size_t OFF_SEL = 496 * MiB;
constexpr size_t WS_END = 500 * MiB;
constexpr int CW_BAR = 1024;

constexpr int LDS_BYTES = 147456, MISC_OFF = 131072 + 320;

typedef unsigned u32x2 __attribute__((ext_vector_type(2)));
typedef float f32x2 __attribute__((ext_vector_type(2)));
#define DI __device__ __forceinline__

struct Params {
    const float* x; const float* norm_w; const float* w_in; const float* b_i; const float* b_f; const float* conv_w; const float* conv_b;
    const float* mnorm_w; const float* qn_w; const float* kn_w; const float* w_out;
    float* out; unsigned char* ws; int ph_lo, ph_hi;
};

DI float bf2f(unsigned short h) { return __uint_as_float((unsigned)h << 16); }
DI float bflo(unsigned w) { return __uint_as_float(w << 16); }
DI float bfhi(unsigned w) { return __uint_as_float(w & 0xffff0000u); }
DI float wave_sum(float v) {
#pragma unroll
    for (int o = 1; o < 64; o <<= 1) v += __shfl_xor(v, o);
    return v;
}
DI float wave_max(float v) {
#pragma unroll
    for (int o = 1; o < 64; o <<= 1) v = fmaxf(v, __shfl_xor(v, o));
    return v;
}
DI float scan_add(float v, int lane) {
#pragma unroll
    for (int o = 1; o < 64; o <<= 1) { const float t = __shfl_up(v, o); if (lane >= o) v += t; }
    return v;
}
DI float scan_max(float v, int lane) {
#pragma unroll
    for (int o = 1; o < 64; o <<= 1) { const float t = __shfl_up(v, o); if (lane >= o) v = fmaxf(v, t); }
    return v;
}
DI float silu_f(float v) { return v / (1.0f + __expf(-v)); }
DI float logsigmoid_f(float f) { return fminf(f, 0.f) - log1pf(__expf(-fabsf(f))); }

struct Ctx { int tid, lane, wave, gw, ngw; LAS unsigned char* lds; };

DI void transpose_item(const float* W, int ldw, int col0, int K, bf16* WT, int row_off, LAS float* scr, int item, int nblk, int lane) {
    const int kb = item / nblk, nb = item % nblk, k0 = 64 * kb, n0 = 32 * nb;
#pragma unroll 8
    for (int i = 0; i < 32; ++i) { const int kk = 2 * i + (lane >> 5); scr[kk * 33 + (lane & 31)] = W[(size_t)(k0 + kk) * ldw + col0 + n0 + (lane & 31)]; }
    LDS_WAIT(); asm volatile("" ::: "memory");
    const int c = lane & 7;
#pragma unroll
    for (int j = 0; j < 4; ++j) { const int n = (lane >> 3) + 8 * j; const LAS float* s = scr + (8 * c) * 33 + n;
        v4u o; o.x = pk2(s[0 * 33], s[1 * 33]); o.y = pk2(s[2 * 33], s[3 * 33]); o.z = pk2(s[4 * 33], s[5 * 33]); o.w = pk2(s[6 * 33], s[7 * 33]);
        *(v4u*)(WT + (size_t)(row_off + n0 + n) * K + k0 + 8 * c) = o; }
    LDS_WAIT(); asm volatile("" ::: "memory");
}
DI void ph_prologue(const Params& P, const Ctx& C) {
    LAS float* scr = (LAS float*)(C.lds + C.wave * 16384);
    constexpr int IA = 16 * 80, IB = 16 * 64, IO = 16 * 32, IL = IA + IB + IO;
    for (int it = C.gw; it < NLAYER * IL; it += C.ngw) {
        const int l = it / IL; int r = it % IL;
        const float* wi = P.w_in + (size_t)l * DM * PROJW; bf16* wt = (bf16*)(P.ws + OFF_WIN) + (size_t)l * PW * DM;
        if (r < IA) { transpose_item(wi, PROJW, 0, DM, wt, 0, scr, r, 80, C.lane); continue; } r -= IA;
        if (r < IB) { transpose_item(wi, PROJW, 2568, DM, wt, 2560, scr, r, 64, C.lane); continue; } r -= IB;
        transpose_item(P.w_out + (size_t)l * DM * DM, DM, 0, DM, (bf16*)(P.ws + OFF_WOUT) + (size_t)l * DM * DM, 0, scr, r, 32, C.lane);
    }
}

DI void ph_norm(const Params& P, const Ctx& C, int layer, const float* xin) {
    const int lane = C.lane;
    LAS f32x4* wgl = (LAS f32x4*)C.lds;
    { const float* wl = P.w_in + (size_t)layer * DM * PROJW + 2560;
      for (int i = C.tid; i < 2048; i += 512) wgl[i] = *(const f32x4*)(wl + (size_t)(i >> 1) * PROJW + 4 * (i & 1)); }
    __syncthreads();
    f32x4 nw[4];
#pragma unroll
    for (int j = 0; j < 4; ++j) nw[j] = *(const f32x4*)(P.norm_w + layer * DM + 256 * j + 4 * lane);
    float bias = 0.f; if (lane < 4) bias = P.b_i[layer * 4 + lane]; else if (lane < 8) bias = P.b_f[layer * 4 + lane - 4];
    bf16* XN = (bf16*)(P.ws + OFF_XN); float* G = (float*)(P.ws + OFF_GATES);
    for (int row = C.gw; row < NTOK; row += C.ngw) {
        const f32x4* xr = (const f32x4*)(xin + (size_t)row * DM) + lane;
        f32x4 v[4]; float ss = 0.f;
#pragma unroll
        for (int j = 0; j < 4; ++j) { v[j] = xr[64 * j]; ss += (v[j].x * v[j].x + v[j].y * v[j].y) + (v[j].z * v[j].z + v[j].w * v[j].w); }
        const float rstd = rsqrtf(wave_sum(ss) * (1.f / DM) + EPS);
        f32x4 g0 = {0.f, 0.f, 0.f, 0.f}, g1 = {0.f, 0.f, 0.f, 0.f};
        unsigned long long* o8 = (unsigned long long*)(XN + (size_t)row * DM) + lane;
#pragma unroll
        for (int j = 0; j < 4; ++j) { const f32x4 h = v[j] * rstd * nw[j];
            o8[64 * j] = (unsigned long long)pk2(h.x, h.y) | ((unsigned long long)pk2(h.z, h.w) << 32);
#pragma unroll
            for (int c = 0; c < 4; ++c) { const int k = 256 * j + 4 * lane + c; g0 += wgl[2 * k] * h[c]; g1 += wgl[2 * k + 1] * h[c]; } }
        float gs[8];
#pragma unroll
        for (int i = 0; i < 4; ++i) { gs[i] = wave_sum(g0[i]); gs[4 + i] = wave_sum(g1[i]); }
        float mine = 0.f;
#pragma unroll
        for (int i = 0; i < 8; ++i) if (lane == i) mine = gs[i];
        if (lane < 8) G[(size_t)row * 8 + lane] = mine + bias;
    }
    __syncthreads();
}

DI void ph_conv_qknorm(const Params& P, const Ctx& C, int layer) {
    const int lane = C.lane;
    bf16* PR = (bf16*)(P.ws + OFF_PROJ); bf16* QKC = (bf16*)(P.ws + OFF_XN);
    float qw[8], kw[8];
#pragma unroll
    for (int i = 0; i < 8; ++i) { qw[i] = P.qn_w[layer * 64 + (lane & 7) * 8 + i]; kw[i] = P.kn_w[layer * 64 + (lane & 7) * 8 + i]; }
    for (int tok = C.gw; tok < NTOK; tok += C.ngw) {
        const int t = tok & (SEQ - 1);
#pragma unroll
        for (int it = 0; it < 2; ++it) {
            const int c = it * 512 + lane * 8;
            float a[8];
#pragma unroll
            for (int i = 0; i < 8; ++i) a[i] = P.conv_b[layer * 1024 + c + i];
#pragma unroll
            for (int k = 0; k < 4; ++k) {
                if (t - 3 + k >= 0) {
                    const v4u xv = *(const v4u*)(PR + (size_t)(tok - 3 + k) * PW + C_MLQK + c);
                    const float* w = P.conv_w + ((size_t)layer * 4 + k) * 1024 + c;
                    a[0] += w[0] * bflo(xv.x); a[1] += w[1] * bfhi(xv.x); a[2] += w[2] * bflo(xv.y); a[3] += w[3] * bfhi(xv.y);
                    a[4] += w[4] * bflo(xv.z); a[5] += w[5] * bfhi(xv.z); a[6] += w[6] * bflo(xv.w); a[7] += w[7] * bfhi(xv.w);
                }
            }
            v4u o; o.x = pk2(silu_f(a[0]), silu_f(a[1])); o.y = pk2(silu_f(a[2]), silu_f(a[3])); o.z = pk2(silu_f(a[4]), silu_f(a[5])); o.w = pk2(silu_f(a[6]), silu_f(a[7]));
            *(v4u*)(QKC + (size_t)tok * 1024 + c) = o;
        }
#pragma unroll
        for (int which = 0; which < 2; ++which) {
            bf16* p = PR + (size_t)tok * PW + (which ? C_ATK : C_ATQ) + lane * 8;
            const v4u xv = *(const v4u*)p;
            float v[8] = {bflo(xv.x), bfhi(xv.x), bflo(xv.y), bfhi(xv.y), bflo(xv.z), bfhi(xv.z), bflo(xv.w), bfhi(xv.w)};
            float ss = 0.f;
#pragma unroll
            for (int i = 0; i < 8; ++i) ss += v[i] * v[i];
            ss += __shfl_xor(ss, 1); ss += __shfl_xor(ss, 2); ss += __shfl_xor(ss, 4);
            const float r = rsqrtf(ss * (1.f / 64.f) + EPS);
#pragma unroll
            for (int i = 0; i < 8; ++i) v[i] = v[i] * r * (which ? kw[i] : qw[i]);
            v4u o; o.x = pk2(v[0], v[1]); o.y = pk2(v[2], v[3]); o.z = pk2(v[4], v[5]); o.w = pk2(v[6], v[7]);
            *(v4u*)p = o;
        }
    }
}

DI void gate_scalars(const float* G, int tok0, int hh, int lane, float (&bb)[4], float (&aa)[4]) {
    float lf[4], ii[4];
#pragma unroll
    for (int j = 0; j < 4; ++j) { const float* g = G + (size_t)(tok0 + 4 * lane + j) * 8; ii[j] = g[hh]; lf[j] = logsigmoid_f(g[4 + hh]); }
    lf[1] += lf[0]; lf[2] += lf[1]; lf[3] += lf[2];
    const float incl = scan_add(lf[3], lane), excl = incl - lf[3];
#pragma unroll
    for (int j = 0; j < 4; ++j) { bb[j] = excl + lf[j]; aa[j] = ii[j] - bb[j]; }
}

DI void ph_cloc_kmean(const Params& P, const Ctx& C) {
    const int lane = C.lane;
    const bf16* PR = (const bf16*)(P.ws + OFF_PROJ); const bf16* QKC = (const bf16*)(P.ws + OFF_XN); const float* G = (const float*)(P.ws + OFF_GATES);
    float* CT = (float*)(P.ws + OFF_CT); float* NL = (float*)(P.ws + OFF_NL); float* MLOC = NL + 8 * 64 * 128; float* BLAST = MLOC + 512;
    LAS float* wts = (LAS float*)(C.lds + C.wave * 16384);
    for (int it = C.gw; it < 8 * NSC * 16; it += C.ngw) {
        const int eg = it & 15, unit = it >> 4, sc = unit & 63, bh = unit >> 6, b = bh >> 2, hh = bh & 3;
        const int tok0 = b * SEQ + sc * SC;
        float bb[4], aa[4]; gate_scalars(G, tok0, hh, lane, bb, aa);
        const float A = wave_max(fmaxf(fmaxf(aa[0], aa[1]), fmaxf(aa[2], aa[3])));
        const float blast = __shfl(bb[3], 63);
#pragma unroll
        for (int j = 0; j < 4; ++j) wts[4 * lane + j] = __expf(aa[j] - A);
        LDS_WAIT(); asm volatile("" ::: "memory");
        float acc[8][2]; float nacc[2] = {0.f, 0.f};
#pragma unroll
        for (int e = 0; e < 8; ++e) { acc[e][0] = 0.f; acc[e][1] = 0.f; }
        for (int t = 0; t < SC; ++t) {
            const unsigned kk = *(const unsigned*)(QKC + (size_t)(tok0 + t) * 1024 + 512 + hh * 128 + 2 * lane);
            const v4u vv = *(const v4u*)(PR + (size_t)(tok0 + t) * PW + C_MLV + hh * 128 + eg * 8);
            const float w = wts[t]; const float k0 = bflo(kk) * w, k1 = bfhi(kk) * w;
            const float ve[8] = {bflo(vv.x), bfhi(vv.x), bflo(vv.y), bfhi(vv.y), bflo(vv.z), bfhi(vv.z), bflo(vv.w), bfhi(vv.w)};
#pragma unroll
            for (int e = 0; e < 8; ++e) { acc[e][0] += k0 * ve[e]; acc[e][1] += k1 * ve[e]; }
            nacc[0] += k0; nacc[1] += k1;
        }
#pragma unroll
        for (int e = 0; e < 8; ++e) *(f32x2*)(CT + ((size_t)unit * 128 + eg * 8 + e) * 128 + 2 * lane) = (f32x2){acc[e][0], acc[e][1]};
        if (eg == 0) { *(f32x2*)(NL + (size_t)unit * 128 + 2 * lane) = (f32x2){nacc[0], nacc[1]}; if (lane == 0) { MLOC[unit] = blast + A; BLAST[unit] = blast; } }
        LDS_WAIT(); asm volatile("" ::: "memory");
    }
    float* KM = (float*)(P.ws + OFF_KMEAN);
    for (int it = C.gw; it < NB * 8 * NBLK; it += C.ngw) {
        const int n = it & 63, h = (it >> 6) & 7, b = it >> 9;
        const bf16* kp = PR + (size_t)(b * SEQ + n * 256) * PW + C_ATK + h * 64 + lane;
        float s = 0.f;
        for (int r = 0; r < 256; ++r) s += bf2f(kp[(size_t)r * PW]);
        KM[(size_t)it * 64 + lane] = s * (1.f / 256.f);
    }
}

DI void ph_scan_select(const Params& P, const Ctx& C) {
    float* CT = (float*)(P.ws + OFF_CT); float* NL = (float*)(P.ws + OFF_NL); float* MLOC = NL + 8 * 64 * 128; float* BLAST = MLOC + 512; float* MPREV = BLAST + 512;
    const int gt = (C.gw >> 3) * 512 + C.tid, ngt = (C.ngw >> 3) * 512;
    for (int idx = gt; idx < 8 * (16384 + 128); idx += ngt) {
        const int bh = idx / 16512, r = idx % 16512;
        float* ptr; int stride;
        if (r < 16384) { ptr = CT + (size_t)bh * 64 * 16384 + r; stride = 16384; } else { ptr = NL + (size_t)bh * 64 * 128 + (r - 16384); stride = 128; }
        float c = 0.f, m = 0.f;
        for (int s0 = 0; s0 < NSC; s0 += 8) {
            float cl[8];
#pragma unroll
            for (int i = 0; i < 8; ++i) cl[i] = ptr[(size_t)(s0 + i) * stride];
#pragma unroll
            for (int i = 0; i < 8; ++i) {
                const float ml = MLOC[bh * 64 + s0 + i], bl = BLAST[bh * 64 + s0 + i];
                ptr[(size_t)(s0 + i) * stride] = c;
                if (r == 0) MPREV[bh * 64 + s0 + i] = m;
                const float mn = fmaxf(bl + m, ml);
                c = __expf(bl + m - mn) * c + __expf(ml - mn) * cl[i];
                m = mn;
            }
        }
    }
    const bf16* PR = (const bf16*)(P.ws + OFF_PROJ); const float* KM = (const float*)(P.ws + OFF_KMEAN); int* SEL = (int*)(P.ws + OFF_SEL);
    for (int idx = gt; idx < NTOK * 8; idx += ngt) {
        const int tok = idx >> 3, h = idx & 7, b = tok >> 14, t = tok & (SEQ - 1), j = t >> 8;
        float q[64];
        const v4u* qp = (const v4u*)(PR + (size_t)tok * PW + C_ATQ + h * 64);
#pragma unroll
        for (int i = 0; i < 8; ++i) { const v4u w = qp[i]; q[8 * i] = bflo(w.x); q[8 * i + 1] = bfhi(w.x); q[8 * i + 2] = bflo(w.y); q[8 * i + 3] = bfhi(w.y); q[8 * i + 4] = bflo(w.z); q[8 * i + 5] = bfhi(w.z); q[8 * i + 6] = bflo(w.w); q[8 * i + 7] = bfhi(w.w); }
        float v0 = -INFINITY, v1 = -INFINITY, v2 = -INFINITY; int i0 = -1, i1 = -1, i2 = -1;
        const float* km = KM + (size_t)((b * 8 + h) * 64) * 64;
        for (int n = 0; n < j; ++n) {
            const f32x4* kp = (const f32x4*)(km + n * 64);
            float d = 0.f;
#pragma unroll
            for (int i = 0; i < 16; ++i) { const f32x4 kv = kp[i]; d += q[4 * i] * kv.x + q[4 * i + 1] * kv.y + q[4 * i + 2] * kv.z + q[4 * i + 3] * kv.w; }
            if (d > v0) { v2 = v1; i2 = i1; v1 = v0; i1 = i0; v0 = d; i0 = n; }
            else if (d > v1) { v2 = v1; i2 = i1; v1 = d; i1 = n; }
            else if (d > v2) { v2 = d; i2 = n; }
        }
        *(int4*)(SEL + (size_t)idx * 4) = make_int4(i0, i1, i2, -1);
    }
}

DI void ph_mixers(const Params& P, const Ctx& C, int layer) {
    const int lane = C.lane;
    const bf16* PR = (const bf16*)(P.ws + OFF_PROJ); const bf16* QKC = (const bf16*)(P.ws + OFF_XN); const float* G = (const float*)(P.ws + OFF_GATES);
    const float* CT = (const float*)(P.ws + OFF_CT); const float* NL = (const float*)(P.ws + OFF_NL); const float* MPREV = NL + 8 * 64 * 128 + 1024;
    bf16* Y = (bf16*)(P.ws + OFF_Y);
    LAS float* sa = (LAS float*)(C.lds + C.wave * 16384);
    LAS float* sM = sa + 256;
    LAS float* sb = sa + 512;
    LAS float* sq = sa + 768;
    for (int it = C.gw; it < 8 * NSC * 8; it += C.ngw) {
        const int tg = it & 7, unit = it >> 3, sc = unit & 63, bh = unit >> 6, b = bh >> 2, hh = bh & 3;
        const int tok0 = b * SEQ + sc * SC;
        float bb[4], aa[4]; gate_scalars(G, tok0, hh, lane, bb, aa);
        const float mprev = MPREV[unit];
        float cm[4]; cm[0] = aa[0]; cm[1] = fmaxf(cm[0], aa[1]); cm[2] = fmaxf(cm[1], aa[2]); cm[3] = fmaxf(cm[2], aa[3]);
        const float incl = scan_max(cm[3], lane); float excl = __shfl_up(incl, 1); if (lane == 0) excl = -INFINITY;
#pragma unroll
        for (int j = 0; j < 4; ++j) { sa[4 * lane + j] = aa[j]; sb[4 * lane + j] = bb[j]; sM[4 * lane + j] = fmaxf(mprev, fmaxf(excl, cm[j])); }
        LDS_WAIT(); asm volatile("" ::: "memory");
        const float* ct = CT + (size_t)unit * 16384; const f32x2 nprev = *(const f32x2*)(NL + (size_t)unit * 128 + 2 * lane);
        const f32x2 mw = *(const f32x2*)(P.mnorm_w + layer * 512 + hh * 128 + 2 * lane);
        for (int tl = tg * 32; tl < tg * 32 + 32; ++tl) {
            const int tok = tok0 + tl;
            const unsigned qq = *(const unsigned*)(QKC + (size_t)tok * 1024 + hh * 128 + 2 * lane);
            const float q0 = bflo(qq) * 0.08838834764831845f, q1 = bfhi(qq) * 0.08838834764831845f;
            sq[2 * lane] = q0; sq[2 * lane + 1] = q1;
            const float Mt = sM[tl], bt = sb[tl];
            float n0 = 0.f, n1 = 0.f, den = 0.f;
            for (int s = 0; s <= tl; ++s) {
                const unsigned kk = *(const unsigned*)(QKC + (size_t)(tok0 + s) * 1024 + 512 + hh * 128 + 2 * lane);
                const unsigned vv = *(const unsigned*)(PR + (size_t)(tok0 + s) * PW + C_MLV + hh * 128 + 2 * lane);
                const float dot = wave_sum(q0 * bflo(kk) + q1 * bfhi(kk));
                const float sv = dot * __expf(sa[s] - Mt);
                den += sv; n0 += sv * bflo(vv); n1 += sv * bfhi(vv);
            }
            LDS_WAIT(); asm volatile("" ::: "memory");
            float c0 = 0.f, c1 = 0.f;
            const f32x4* r0 = (const f32x4*)(ct + (size_t)(2 * lane) * 128); const f32x4* r1 = (const f32x4*)(ct + (size_t)(2 * lane + 1) * 128);
#pragma unroll 8
            for (int d4 = 0; d4 < 32; ++d4) { const f32x4 a = r0[d4], bq = r1[d4]; const float qa = sq[4 * d4], qb = sq[4 * d4 + 1], qc = sq[4 * d4 + 2], qd = sq[4 * d4 + 3];
                c0 += qa * a.x + qb * a.y + qc * a.z + qd * a.w; c1 += qa * bq.x + qb * bq.y + qc * bq.z + qd * bq.w; }
            const float qn = wave_sum(q0 * nprev.x + q1 * nprev.y);
            const float si = __expf(mprev - Mt);
            n0 += si * c0; n1 += si * c1; den += si * qn;
            const float dn = fmaxf(fabsf(den), __expf(-(bt + Mt)));
            const unsigned oo = *(const unsigned*)(PR + (size_t)tok * PW + C_MLO + hh * 128 + 2 * lane);
            const unsigned zz = *(const unsigned*)(PR + (size_t)tok * PW + C_MLZ + hh * 128 + 2 * lane);
            const float h0 = bflo(oo) * n0 / dn, h1 = bfhi(oo) * n1 / dn;
            const float r = rsqrtf(wave_sum(h0 * h0 + h1 * h1) * (1.f / 128.f) + EPS);
            *(unsigned*)(Y + (size_t)tok * 1024 + hh * 128 + 2 * lane) = pk2(h0 * r * mw.x * bflo(zz), h1 * r * mw.y * bfhi(zz));
            LDS_WAIT(); asm volatile("" ::: "memory");
        }
    }
    const int* SEL = (const int*)(P.ws + OFF_SEL);
    for (int it = C.gw; it < NTOK * 8; it += C.ngw) {
        const int tok = it >> 3, h = it & 7, b = tok >> 14, t = tok & (SEQ - 1), j = t >> 8;
        const float slope = exp2f(-(float)(h + 1));
        float q[64];
        const v4u* qp = (const v4u*)(PR + (size_t)tok * PW + C_ATQ + h * 64);
#pragma unroll
        for (int i = 0; i < 8; ++i) { const v4u w = qp[i]; q[8 * i] = bflo(w.x); q[8 * i + 1] = bfhi(w.x); q[8 * i + 2] = bflo(w.y); q[8 * i + 3] = bfhi(w.y); q[8 * i + 4] = bflo(w.z); q[8 * i + 5] = bfhi(w.z); q[8 * i + 6] = bflo(w.w); q[8 * i + 7] = bfhi(w.w); }
        const int4 sel = *(const int4*)(SEL + (size_t)it * 4);
        float m = -1e30f, l = 0.f, o = 0.f;
        for (int bi = 0; bi < 4; ++bi) {
            const int n = bi == 0 ? sel.x : bi == 1 ? sel.y : bi == 2 ? sel.z : j;
            if (n < 0) continue;
            const int nst = (bi == 3) ? ((t & 255) >> 6) + 1 : 4;
            for (int st = 0; st < nst; ++st) {
                const int s = n * 256 + st * 64 + lane;
                const v4u* kp = (const v4u*)(PR + (size_t)(b * SEQ + s) * PW + C_ATK + h * 64);
                float d = 0.f;
#pragma unroll
                for (int i = 0; i < 8; ++i) { const v4u w = kp[i]; d += q[8 * i] * bflo(w.x) + q[8 * i + 1] * bfhi(w.x) + q[8 * i + 2] * bflo(w.y) + q[8 * i + 3] * bfhi(w.y) + q[8 * i + 4] * bflo(w.z) + q[8 * i + 5] * bfhi(w.z) + q[8 * i + 6] * bflo(w.w) + q[8 * i + 7] * bfhi(w.w); }
                float scv = d * 0.125f - slope * (float)(t - s);
                if (s > t) scv = -INFINITY;
                const float mn = fmaxf(m, wave_max(scv));
                const float p = __expf(scv - mn), corr = __expf(m - mn);
                l = l * corr + wave_sum(p); o *= corr; m = mn;
                const bf16* vp = PR + (size_t)(b * SEQ + n * 256 + st * 64) * PW + C_ATV + h * 64 + lane;
#pragma unroll 8
                for (int kk = 0; kk < 64; ++kk) o += __shfl(p, kk) * bf2f(vp[(size_t)kk * PW]);
            }
        }
        const float z = bf2f(PR[(size_t)tok * PW + C_ATZ + h * 64 + lane]);
        Y[(size_t)tok * 1024 + 512 + h * 64 + lane] = (bf16)f2bf(o / l * z);
    }
}

typedef const __attribute__((address_space(4))) Params* KargPtr;
__global__ void __launch_bounds__(512, 2) fwd_kernel(Params P_karg) {
    extern __shared__ __attribute__((aligned(16))) unsigned char lds_raw[];
    LAS unsigned char* const lds0 = (LAS unsigned char*)lds_raw;
    for (int u = threadIdx.x; u < 64; u += 512) ((LAS unsigned*)(lds0 + 131072))[u + 80] = 0u;
    __syncthreads();
    int gp, hi;
    { KargPtr pk = (KargPtr)__builtin_amdgcn_kernarg_segment_ptr(); gp = pk->ph_lo; hi = pk->ph_hi;
      if (hi - gp > 1) (void)xcd_barrier_post((unsigned*)(pk->ws + OFF_CTL) + CW_BAR, (volatile LAS unsigned*)(lds0 + MISC_OFF) + 8); }
    for (; gp < hi; ++gp) {
        KargPtr pk = (KargPtr)__builtin_amdgcn_kernarg_segment_ptr(); asm volatile("" : "+s"(pk));
        Params P; P.x = pk->x; P.norm_w = pk->norm_w; P.w_in = pk->w_in; P.b_i = pk->b_i; P.b_f = pk->b_f; P.conv_w = pk->conv_w; P.conv_b = pk->conv_b;
        P.mnorm_w = pk->mnorm_w; P.qn_w = pk->qn_w; P.kn_w = pk->kn_w; P.w_out = pk->w_out; P.out = pk->out; P.ws = pk->ws; P.ph_lo = 0; P.ph_hi = 0;
        int tid_ = threadIdx.x; asm volatile("" : "+v"(tid_));
        Ctx C; C.lds = lds0; C.tid = tid_; C.lane = tid_ & 63; C.wave = __builtin_amdgcn_readfirstlane(tid_ >> 6);
        int bid_ = blockIdx.x, gdim_ = gridDim.x; asm volatile("" : "+s"(bid_), "+s"(gdim_));
        C.gw = bid_ * 8 + C.wave; C.ngw = gdim_ * 8;
        if (gp == 0) ph_prologue(P, C);
        else {
            const int layer = (gp - 1) / NPH, ph = (gp - 1) % NPH;
            const float* xin = layer == 0 ? P.x : P.out;
            if (ph == 0) ph_norm(P, C, layer, xin);
            else if (ph == 1) {
                pg8::Gemm g{(const pg8::bf16_t*)(P.ws + OFF_XN), (const pg8::bf16_t*)(P.ws + OFF_WIN) + (size_t)layer * PW * DM, NTOK, PW, DM};
                pg8::StaticOrder S; S.init(NTOK, PW, gdim_, bid_);
                const unsigned long long acts = (1ull << 12) | (1ull << 14) | (2ull << 16) | (2ull << 18) | (2ull << 32) | (2ull << 34);
                pg8::EpiProj E{(pg8::bf16_t*)(P.ws + OFF_PROJ), PW, acts};
                pg8::gemm_phase<pg8::EpiProj, pg8::StaticOrder, true, true>(C.lds, g, S, E);
            }
            else if (ph == 2) ph_conv_qknorm(P, C, layer);
            else if (ph == 3) ph_cloc_kmean(P, C);
            else if (ph == 4) ph_scan_select(P, C);
            else if (ph == 5) ph_mixers(P, C, layer);
            else {
                pg8::Gemm g{(const pg8::bf16_t*)(P.ws + OFF_Y), (const pg8::bf16_t*)(P.ws + OFF_WOUT) + (size_t)layer * DM * DM, NTOK, DM, DM};
                pg8::StaticOrder S; S.init(NTOK, DM, gdim_, bid_);
                pg8::EpiRes E{xin, P.out, DM};
                pg8::gemm_phase<pg8::EpiRes, pg8::StaticOrder, true, true>(C.lds, g, S, E);
            }
        }
        if (gp + 1 < hi) {
            KargPtr pb = (KargPtr)__builtin_amdgcn_kernarg_segment_ptr(); asm volatile("" : "+s"(pb));
            XcdBarrier bar; bar.bar = (unsigned*)(pb->ws + OFF_CTL) + CW_BAR; bar.x = xb_xcc_id(); bar.st = (volatile LAS unsigned*)(lds0 + MISC_OFF) + 8;
            xcd_barrier(bar);
        }
    }
}

#ifndef ONE_LAUNCH
#define ONE_LAUNCH 1
#endif
extern "C" void kernel_launch(void* const* d_in, const int* in_sizes, int n_in, void* d_out, int out_size, void* d_ws, size_t ws_size, hipStream_t stream) {
    static int grid = 0;
    if (grid == 0) {
        if (n_in != 11 || in_sizes[0] != NTOK * DM || out_size != NTOK * DM || ws_size < WS_END) { fprintf(stderr, "kernel_launch: unexpected shapes (n_in %d, in0 %d, out %d, ws %zu)\n", n_in, n_in > 0 ? in_sizes[0] : -1, out_size, ws_size); grid = -1; return; }
        int dev = 0, cus = 0, per_cu = 0;
        if (hipGetDevice(&dev) != hipSuccess || hipDeviceGetAttribute(&cus, hipDeviceAttributeMultiprocessorCount, dev) != hipSuccess) { grid = -1; return; }
        if (hipFuncSetAttribute((const void*)fwd_kernel, hipFuncAttributeMaxDynamicSharedMemorySize, LDS_BYTES) != hipSuccess) { fprintf(stderr, "kernel_launch: hipFuncSetAttribute failed\n"); grid = -1; return; }
        if (hipOccupancyMaxActiveBlocksPerMultiprocessor(&per_cu, (const void*)fwd_kernel, 512, LDS_BYTES) != hipSuccess || per_cu < 1) { fprintf(stderr, "kernel_launch: occupancy query says %d blocks per CU\n", per_cu); per_cu = 1; }
        (void)hipGetLastError();
        grid = cus;
    }
    if (grid < 0) return;
    (void)hipMemsetAsync((char*)d_ws + OFF_CTL, 0, CTL_BYTES, stream);
    Params p{};
    p.x = (const float*)d_in[0]; p.norm_w = (const float*)d_in[1]; p.w_in = (const float*)d_in[2]; p.b_i = (const float*)d_in[3]; p.b_f = (const float*)d_in[4];
    p.conv_w = (const float*)d_in[5]; p.conv_b = (const float*)d_in[6]; p.mnorm_w = (const float*)d_in[7]; p.qn_w = (const float*)d_in[8]; p.kn_w = (const float*)d_in[9]; p.w_out = (const float*)d_in[10];
    p.out = (float*)d_out; p.ws = (unsigned char*)d_ws;
#if ONE_LAUNCH
    p.ph_lo = 0; p.ph_hi = NGP;
    hipLaunchKernelGGL(fwd_kernel, dim3(grid), dim3(512), LDS_BYTES, stream, p);
#else
    for (int gp = 0; gp < NGP; ++gp) { p.ph_lo = gp; p.ph_hi = gp + 1; hipLaunchKernelGGL(fwd_kernel, dim3(grid), dim3(512), LDS_BYTES, stream, p); }
#endif
}
```

```cpp
#include <hip/hip_runtime.h>
#include <cstdio>
#include <cstdint>
#ifndef TS_SCALE
#define TS_SCALE 1.0f
#endif
#ifndef TS_PROBE
#define TS_PROBE -1
#endif
#define TS_DECL unsigned long long ts_last_ = 0; const bool ts_on_ = (TS_PROBE >= 70) && (C.gw >> 3) == 0 && C.wave == 7 && C.lane == 0; unsigned* ts_acc_ = (unsigned*)(P.ws) + 16384 + 256
#define TS_RESET() do { if (ts_on_) ts_last_ = __builtin_amdgcn_s_memrealtime(); } while (0)
#define TS_MARK(k) do { if (ts_on_) { const unsigned long long now_ = __builtin_amdgcn_s_memrealtime(); ts_acc_[k] += (unsigned)(now_ - ts_last_); ts_last_ = now_; } } while (0)
namespace pg8 {
#define PG8_LAS __attribute__((address_space(3)))
typedef unsigned short bf16_t;
typedef short bf16x8 __attribute__((ext_vector_type(8)));
typedef float f32x4 __attribute__((ext_vector_type(4)));
typedef unsigned u32x4 __attribute__((ext_vector_type(4)));
constexpr int BM = 256, BK = 64, HALF = 128, HTB = HALF * BK * 2  , STAGE_BYTES = 8 * HTB, NXCD = 8, WGM = 8;

__host__ __device__ __forceinline__ int lds_byte(int r, int c) { const int st = (r >> 4) * 2 + (c >> 5), rr = r & 15, cc = c & 31, ob = rr * 64 + cc * 2; return st * 1024 + (ob ^ (((ob >> 9) & 1) << 5)); }
__host__ __device__ __forceinline__ void stage_rc(int b, int& R, int& C) { const int st = b / 1024, sb = b % 1024, swz = sb ^ (((sb >> 9) & 1) << 5); R = (st >> 1) * 16 + swz / 64; C = (st & 1) * 32 + (swz % 64) / 2; }
__host__ __device__ __forceinline__ int perm32(int rho) { const int n = rho >> 4, i = rho & 15; return 8 * (i >> 2) + 4 * n + (i & 3); }

struct Unit { int pm, pn; };
struct Gemm { const bf16_t* A; const bf16_t* Bt; int M, N, K; };

struct StaticOrder {
    int nM, nN, nwg, G, c;
    __host__ __device__ void init(int M, int N, int G_, int c_) { nM = M / BM; nN = N / BM; nwg = nM * nN; G = G_; c = c_; }
    __host__ __device__ bool next(int i, Unit& u) const {
        const long L = (long)i * G + c; if (L >= nwg) return false;
        int wgid = (int)L; { const int q = nwg / NXCD, r = nwg % NXCD, xcd = wgid % NXCD, off = wgid / NXCD; wgid = (xcd < r ? xcd * (q + 1) : r * (q + 1) + (xcd - r) * q) + off; }
        const int nig = WGM * nN, gid = wgid / nig, fm = gid * WGM, gsz = (nM - fm) < WGM ? (nM - fm) : WGM;
        u.pm = fm + ((wgid % nig) % gsz); u.pn = (wgid % nig) / gsz; return true;
    }
    __device__ __forceinline__ void a_ready(const Unit&) const {}
    __device__ __forceinline__ void done(const Unit&) const {}
};

__device__ __forceinline__ unsigned cvt_pk_bf16(float lo, float hi) { unsigned r; asm volatile("v_cvt_pk_bf16_f32 %0, %1, %2" : "=v"(r) : "v"(lo), "v"(hi)); return r; }
typedef float f32x2 __attribute__((ext_vector_type(2)));
__device__ __forceinline__ float sigmoid_f(float v) { return __builtin_amdgcn_rcpf(1.0f + __builtin_amdgcn_exp2f(v * -1.4426950408889634f)); }
struct EpiProj {
    static constexpr bool PERM = true, AFTER_DRAIN = false;
    bf16_t* O; int seq_log2; unsigned long long acts; const float* qw; const float* kw;
    float* kmp;
    const float* ssq;
    __device__ __forceinline__ void operator()(const f32x4 (&acc)[2][2][4][2], const Unit& u, int wr, int wc, int fr, int fq) const {
        const int row0 = u.pm * BM + wr * 64 + fr, seq = 1 << seq_log2;
        const int act = (int)((acts >> (2 * u.pn)) & 3ull), sec = u.pn >> 1;
        bf16_t* secp = O + (size_t)sec * ((size_t)(2 * seq) * 512);
        float rs[2][4];
#pragma unroll
        for (int ai = 0; ai < 2; ++ai)
#pragma unroll
            for (int m = 0; m < 4; ++m) { const f32x4 s0 = *(const f32x4*)(ssq + (size_t)(row0 + ai * HALF + m * 16) * 16 + 4 * fq);
                float t = (s0[0] + s0[1]) + (s0[2] + s0[3]); t += __shfl_xor(t, 16); t += __shfl_xor(t, 32);
                rs[ai][m] = rsqrtf(t * (1.0f / 1024.0f) + 1e-6f); }
        if (act == 3) {
            const float* nw = (u.pn < 12 ? qw : kw) + 8 * fq;
            const f32x4 w00 = *(const f32x4*)(nw), w01 = *(const f32x4*)(nw + 4), w10 = *(const f32x4*)(nw + 32), w11 = *(const f32x4*)(nw + 36);
            const int head = (u.pn & 1) * 4 + wc;
            f32x4 ksum[4] = {{0.f, 0.f, 0.f, 0.f}, {0.f, 0.f, 0.f, 0.f}, {0.f, 0.f, 0.f, 0.f}, {0.f, 0.f, 0.f, 0.f}};
#pragma unroll
            for (int ai = 0; ai < 2; ++ai)
#pragma unroll
                for (int m = 0; m < 4; ++m) { const int r = row0 + ai * HALF + m * 16, b = r >> seq_log2, t = r & (seq - 1);
                    bf16_t* rowp = secp + ((size_t)(b * 8 + head) * seq + t) * 64 + 8 * fq;
                    const float rr = rs[ai][m]; f32x4 a = acc[ai][0][m][0] * rr, bb = acc[ai][0][m][1] * rr, c = acc[ai][1][m][0] * rr, d = acc[ai][1][m][1] * rr;
                    float ss = ((a[0] * a[0] + a[1] * a[1]) + (a[2] * a[2] + a[3] * a[3])) + ((bb[0] * bb[0] + bb[1] * bb[1]) + (bb[2] * bb[2] + bb[3] * bb[3]))
                             + ((c[0] * c[0] + c[1] * c[1]) + (c[2] * c[2] + c[3] * c[3])) + ((d[0] * d[0] + d[1] * d[1]) + (d[2] * d[2] + d[3] * d[3]));
                    ss += __shfl_xor(ss, 16); ss += __shfl_xor(ss, 32);
                    const float rn = rsqrtf(ss * (1.0f / 64.0f) + 1e-6f);
                    a = a * rn * w00; bb = bb * rn * w01; c = c * rn * w10; d = d * rn * w11;
                    u32x4 w; w.x = cvt_pk_bf16(a[0], a[1]); w.y = cvt_pk_bf16(a[2], a[3]); w.z = cvt_pk_bf16(bb[0], bb[1]); w.w = cvt_pk_bf16(bb[2], bb[3]);
                    *(u32x4*)(rowp) = w;
                    w.x = cvt_pk_bf16(c[0], c[1]); w.y = cvt_pk_bf16(c[2], c[3]); w.z = cvt_pk_bf16(d[0], d[1]); w.w = cvt_pk_bf16(d[2], d[3]);
                    *(u32x4*)(rowp + 32) = w;
                    ksum[0] += a; ksum[1] += bb; ksum[2] += c; ksum[3] += d; }
            if (u.pn >= 12) {
#pragma unroll
                for (int v = 0; v < 4; ++v)
#pragma unroll
                    for (int i = 0; i < 4; ++i) { float x = ksum[v][i]; x += __shfl_xor(x, 1); x += __shfl_xor(x, 2); x += __shfl_xor(x, 4); x += __shfl_xor(x, 8); ksum[v][i] = x; }
                int fql = fq; asm volatile("" : "+v"(fql));
                if (fr == 0) { float* kp = kmp + ((((size_t)(u.pm >> 6) * 8 + head) * 64 + (u.pm & 63)) * 2 + wr) * 64 + 8 * fql;
                    *(f32x4*)(kp) = ksum[0]; *(f32x4*)(kp + 4) = ksum[1]; *(f32x4*)(kp + 32) = ksum[2]; *(f32x4*)(kp + 36) = ksum[3]; }
            }
            return;
        }
        const bool wide = sec < 5;
#pragma unroll
        for (int ai = 0; ai < 2; ++ai)
#pragma unroll
            for (int m = 0; m < 4; ++m) { const int r = row0 + ai * HALF + m * 16, b = r >> seq_log2, t = r & (seq - 1);
#pragma unroll
                for (int bj = 0; bj < 2; ++bj) { f32x4 v0 = acc[ai][bj][m][0] * rs[ai][m], v1 = acc[ai][bj][m][1] * rs[ai][m];
                    if (act != 0) {
#pragma unroll
                        for (int i = 0; i < 4; ++i) { const float s0 = sigmoid_f(v0[i]), s1 = sigmoid_f(v1[i]); v0[i] = (act == 1) ? s0 : v0[i] * s0; v1[i] = (act == 1) ? s1 : v1[i] * s1; }
                    }
                    bf16_t* dst = wide ? secp + ((size_t)(b * 4 + (u.pn & 1) * 2 + bj) * seq + t) * 128 + 32 * wc + 8 * fq
                                       : secp + ((size_t)(b * 8 + (u.pn & 1) * 4 + 2 * bj + (wc >> 1)) * seq + t) * 64 + (wc & 1) * 32 + 8 * fq;
                    u32x4 w; w.x = cvt_pk_bf16(v0[0], v0[1]); w.y = cvt_pk_bf16(v0[2], v0[3]); w.z = cvt_pk_bf16(v1[0], v1[1]); w.w = cvt_pk_bf16(v1[2], v1[3]);
                    *(u32x4*)dst = w; } }
    }
};
struct EpiRes {
    static constexpr bool PERM = true, AFTER_DRAIN = false;
    bf16_t* xb; float* out; float* ssq; int ldc; int last; float scale;
    __device__ __forceinline__ void operator()(const f32x4 (&acc)[2][2][4][2], const Unit& u, int wr, int wc, int fr, int fq) const {
        const int col0 = u.pn * BM + wc * 32 + 8 * fq;
#pragma unroll
        for (int ai = 0; ai < 2; ++ai)
#pragma unroll
            for (int m = 0; m < 4; ++m) { const int row = u.pm * BM + ai * HALF + wr * 64 + m * 16 + fr; const size_t off = (size_t)row * ldc + col0; float sq = 0.f;
#pragma unroll
                for (int bj = 0; bj < 2; ++bj) { const u32x4 xr = *(const u32x4*)(xb + off + bj * HALF);
                    f32x4 v0 = acc[ai][bj][m][0] * scale, v1 = acc[ai][bj][m][1] * scale;
                    v0[0] += __uint_as_float(xr.x << 16); v0[1] += __uint_as_float(xr.x & 0xffff0000u); v0[2] += __uint_as_float(xr.y << 16); v0[3] += __uint_as_float(xr.y & 0xffff0000u);
                    v1[0] += __uint_as_float(xr.z << 16); v1[1] += __uint_as_float(xr.z & 0xffff0000u); v1[2] += __uint_as_float(xr.w << 16); v1[3] += __uint_as_float(xr.w & 0xffff0000u);
                    if (last) { *(f32x4*)(out + off + bj * HALF) = v0; *(f32x4*)(out + off + bj * HALF + 4) = v1; }
                    else { u32x4 w; w.x = cvt_pk_bf16(v0[0], v0[1]); w.y = cvt_pk_bf16(v0[2], v0[3]); w.z = cvt_pk_bf16(v1[0], v1[1]); w.w = cvt_pk_bf16(v1[2], v1[3]); *(u32x4*)(xb + off + bj * HALF) = w;
                        sq += ((v0[0] * v0[0] + v0[1] * v0[1]) + (v0[2] * v0[2] + v0[3] * v0[3])) + ((v1[0] * v1[0] + v1[1] * v1[1]) + (v1[2] * v1[2] + v1[3] * v1[3])); } }
                if (!last) { sq += __shfl_xor(sq, 16); sq += __shfl_xor(sq, 32); if (fq == 0) ssq[(size_t)row * 16 + u.pn * 4 + wc] = sq; } }
    }
};
template <class Epi, class Sched, bool ALIGN_EPI = false, bool SP2 = false>
__device__ __forceinline__ void gemm_phase(PG8_LAS unsigned char* lds, const Gemm g, const Sched& S, const Epi& E, int tid_in) {
    int tid_l = tid_in; asm volatile("" : "+v"(tid_l));
    const int tid = tid_l, wid = __builtin_amdgcn_readfirstlane(tid >> 6), lane = tid & 63, wr = wid >> 2, wc = wid & 3, fr = lane & 15, fq = lane >> 4;
    const int K = g.K, nt = K / BK;
    unsigned voffA[2], voffB[2];
#pragma unroll
    for (int i = 0; i < 2; ++i) { int R, C; stage_rc(tid * 16 + i * 8192, R, C); const int Rb = Epi::PERM ? ((R & ~31) + perm32(R & 31)) : R;
        voffA[i] = (unsigned)(R * K + C) * 2u; voffB[i] = (unsigned)(Rb * K + C) * 2u; }
    const size_t kstep = (size_t)(BK * 2);
    const size_t hstep = (size_t)HALF * K * 2;
    const size_t tstep = 2 * hstep;
    const unsigned ldsw = (unsigned)wid * 1024u;
    const int aoff = lds_byte(wr * 64 + fr, fq * 8), boff = lds_byte(wc * 32 + fr, fq * 8);
#define PG8_SA(b, h) (((b) * 2 + (h)) * HTB)
#define PG8_SB(b, h) ((4 + (b) * 2 + (h)) * HTB)
#define PG8_STAGE(bufoff, gbase, voff) do { _Pragma("unroll") for (int _i = 0; _i < 2; ++_i) \
        __builtin_amdgcn_global_load_lds((const unsigned*)((const char*)(gbase) + (voff)[_i]), (PG8_LAS unsigned*)(lds + (bufoff) + ldsw + _i * 8192), 16, 0, 0); } while (0)
#define PG8_LDA(dst, b, h) do { _Pragma("unroll") for (int m = 0; m < 4; ++m) _Pragma("unroll") for (int k = 0; k < 2; ++k) dst[m][k] = *(const PG8_LAS bf16x8*)(lds + PG8_SA(b, h) + aoff + m * 2048 + k * 1024); } while (0)
#define PG8_LDB(dst, b, h) do { _Pragma("unroll") for (int n = 0; n < 2; ++n) _Pragma("unroll") for (int k = 0; k < 2; ++k) dst[n][k] = *(const PG8_LAS bf16x8*)(lds + PG8_SB(b, h) + boff + n * 2048 + k * 1024); } while (0)
#define PG8_MMA(ai, bj, At, Bt) do { __builtin_amdgcn_s_setprio(1); _Pragma("unroll") for (int m = 0; m < 4; ++m) _Pragma("unroll") for (int n = 0; n < 2; ++n) _Pragma("unroll") for (int k = 0; k < 2; ++k) \
        acc[ai][bj][m][n] = __builtin_amdgcn_mfma_f32_16x16x32_bf16(Bt[n][k], At[m][k], acc[ai][bj][m][n], 0, 0, 0); __builtin_amdgcn_s_setprio(0); } while (0)
#define PG8_WAIT_V(n) asm volatile("s_waitcnt vmcnt(" #n ")" ::: "memory")
#define PG8_WAIT_L(n) asm volatile("s_waitcnt lgkmcnt(" #n ")" ::: "memory")
#define PG8_BAR __builtin_amdgcn_s_barrier()
#define PG8_SCHED __builtin_amdgcn_sched_barrier(0)
    Unit cur, nxt; int ui = 0;
    if (!S.next(0, cur)) return;
    f32x4 acc[2][2][4][2];
#pragma unroll
    for (int a = 0; a < 2; ++a)
#pragma unroll
        for (int b = 0; b < 2; ++b)
#pragma unroll
            for (int m = 0; m < 4; ++m)
#pragma unroll
                for (int n = 0; n < 2; ++n) acc[a][b][m][n] = (f32x4){0.f, 0.f, 0.f, 0.f};
    bf16x8 At[4][2], B0[2][2], B1[2][2];
    const char* cA = (const char*)g.A + (size_t)cur.pm * tstep; const char* cB = (const char*)g.Bt + (size_t)cur.pn * tstep;
    S.a_ready(cur);
    if constexpr (SP2) {
        PG8_STAGE(PG8_SB(0, 0), cB, voffB); PG8_STAGE(PG8_SB(0, 1), cB + hstep, voffB); PG8_STAGE(PG8_SA(0, 0), cA, voffA); PG8_STAGE(PG8_SA(0, 1), cA + hstep, voffA);
        if (wr == 1) PG8_BAR;
        PG8_WAIT_V(2); PG8_BAR;
        PG8_STAGE(PG8_SB(1, 0), cB + kstep, voffB); PG8_STAGE(PG8_SA(1, 0), cA + kstep, voffA); PG8_STAGE(PG8_SB(1, 1), cB + hstep + kstep, voffB);
        PG8_WAIT_V(6); PG8_BAR;
    } else {
        PG8_STAGE(PG8_SB(0, 0), cB, voffB); PG8_STAGE(PG8_SA(0, 0), cA, voffA); PG8_STAGE(PG8_SB(0, 1), cB + hstep, voffB); PG8_STAGE(PG8_SA(0, 1), cA + hstep, voffA);
        if (wr == 1) PG8_BAR;
        PG8_WAIT_V(4); PG8_BAR;
        PG8_STAGE(PG8_SB(1, 0), cB + kstep, voffB); PG8_STAGE(PG8_SA(1, 0), cA + kstep, voffA); PG8_STAGE(PG8_SB(1, 1), cB + hstep + kstep, voffB);
        PG8_WAIT_V(6); PG8_BAR;
    }
    for (;;) {
        const bool has_next = S.next(ui + 1, nxt);
        const char* nA = has_next ? (const char*)g.A + (size_t)nxt.pm * tstep : cA; const char* nB = has_next ? (const char*)g.Bt + (size_t)nxt.pn * tstep : cB;
        for (int t = 0; t < nt; t += 2) {
            const bool last = (t == nt - 2);
            const char* a1 = cA + (size_t)(t + 1) * kstep;
            const char* a2 = last ? nA : cA + (size_t)(t + 2) * kstep; const char* b2 = last ? nB : cB + (size_t)(t + 2) * kstep;
            const char* a3 = a2 + kstep; const char* b3 = b2 + kstep;
            if (last && has_next) S.a_ready(nxt);
            if constexpr (SP2) {
            PG8_LDB(B0, 0, 0); PG8_LDB(B1, 0, 1); PG8_SCHED; PG8_LDA(At, 0, 0); PG8_STAGE(PG8_SA(1, 1), a1 + hstep, voffA);
            PG8_WAIT_V(8); PG8_WAIT_L(0); PG8_BAR; PG8_MMA(0, 0, At, B0); PG8_MMA(0, 1, At, B1); PG8_BAR; PG8_SCHED;
            PG8_LDA(At, 0, 1); PG8_STAGE(PG8_SB(0, 0), b2, voffB); PG8_STAGE(PG8_SB(0, 1), b2 + hstep, voffB); PG8_STAGE(PG8_SA(0, 0), a2, voffA);
            PG8_WAIT_V(8); PG8_WAIT_L(0); PG8_BAR; PG8_MMA(1, 0, At, B0); PG8_MMA(1, 1, At, B1); PG8_BAR; PG8_SCHED;
            PG8_LDB(B0, 1, 0); PG8_LDB(B1, 1, 1); PG8_SCHED; PG8_LDA(At, 1, 0); PG8_STAGE(PG8_SA(0, 1), a2 + hstep, voffA);
            PG8_WAIT_V(8); PG8_WAIT_L(0); PG8_BAR; PG8_MMA(0, 0, At, B0); PG8_MMA(0, 1, At, B1); PG8_BAR; PG8_SCHED;
            PG8_LDA(At, 1, 1); PG8_STAGE(PG8_SB(1, 0), b3, voffB); PG8_STAGE(PG8_SB(1, 1), b3 + hstep, voffB); PG8_STAGE(PG8_SA(1, 0), a3, voffA);
            PG8_WAIT_V(8); PG8_WAIT_L(0); PG8_BAR; PG8_MMA(1, 0, At, B0); PG8_MMA(1, 1, At, B1); PG8_BAR; PG8_SCHED;
            } else {
            PG8_LDB(B0, 0, 0); PG8_SCHED; PG8_LDA(At, 0, 0); PG8_STAGE(PG8_SA(1, 1), a1 + hstep, voffA);
            PG8_WAIT_L(8); PG8_BAR; PG8_WAIT_L(0); PG8_MMA(0, 0, At, B0); PG8_BAR; PG8_SCHED;
            PG8_LDB(B1, 0, 1); PG8_STAGE(PG8_SB(0, 0), b2, voffB);
            PG8_BAR; PG8_WAIT_L(0); PG8_MMA(0, 1, At, B1); PG8_BAR;
            PG8_LDA(At, 0, 1); PG8_STAGE(PG8_SA(0, 0), a2, voffA);
            PG8_BAR; PG8_WAIT_L(0); PG8_MMA(1, 0, At, B0); PG8_BAR; PG8_SCHED;
            PG8_STAGE(PG8_SB(0, 1), b2 + hstep, voffB);
            PG8_WAIT_V(6); PG8_BAR; PG8_MMA(1, 1, At, B1); PG8_BAR;
            PG8_LDB(B0, 1, 0); PG8_SCHED; PG8_LDA(At, 1, 0); PG8_STAGE(PG8_SA(0, 1), a2 + hstep, voffA);
            PG8_WAIT_L(8); PG8_BAR; PG8_WAIT_L(0); PG8_MMA(0, 0, At, B0); PG8_BAR; PG8_SCHED;
            PG8_LDB(B1, 1, 1); PG8_STAGE(PG8_SB(1, 0), b3, voffB);
            PG8_BAR; PG8_WAIT_L(0); PG8_MMA(0, 1, At, B1); PG8_BAR;
            PG8_LDA(At, 1, 1); PG8_STAGE(PG8_SA(1, 0), a3, voffA);
            PG8_BAR; PG8_WAIT_L(0); PG8_MMA(1, 0, At, B0); PG8_BAR; PG8_SCHED;
            PG8_STAGE(PG8_SB(1, 1), b3 + hstep, voffB);
            PG8_WAIT_V(6); PG8_BAR; PG8_MMA(1, 1, At, B1); PG8_BAR;
            }
        }
        if constexpr (ALIGN_EPI) { if (wr == 0) PG8_BAR; }
        if constexpr (!Epi::AFTER_DRAIN) { E(acc, cur, wr, wc, fr, fq); S.done(cur); }
        if (!has_next) break;
#pragma unroll
        for (int a = 0; a < 2; ++a)
#pragma unroll
            for (int b = 0; b < 2; ++b)
#pragma unroll
                for (int m = 0; m < 4; ++m)
#pragma unroll
                    for (int n = 0; n < 2; ++n) acc[a][b][m][n] = (f32x4){0.f, 0.f, 0.f, 0.f};
        cur = nxt; cA = nA; cB = nB; ++ui;
        if constexpr (ALIGN_EPI) { if (wr == 1) PG8_BAR; }
    }
    PG8_WAIT_V(0);
    if constexpr (!ALIGN_EPI) { if (wr == 0) PG8_BAR; }
    PG8_BAR;
    if constexpr (Epi::AFTER_DRAIN) { E.fused(acc, cur, wr, wc, fr, fq, lds, wid, lane); S.done(cur); }
#undef PG8_SA
#undef PG8_SB
#undef PG8_STAGE
#undef PG8_LDA
#undef PG8_LDB
#undef PG8_MMA
#undef PG8_WAIT_V
#undef PG8_WAIT_L
#undef PG8_BAR
#undef PG8_SCHED
}
}
#define GAS __attribute__((address_space(1)))
#define LAS __attribute__((address_space(3)))
typedef unsigned short bf16;
typedef unsigned v4u __attribute__((ext_vector_type(4)));
typedef float f32x4 __attribute__((ext_vector_type(4)));
typedef short bf16x8 __attribute__((ext_vector_type(8)));
typedef GAS unsigned gu32;
typedef GAS unsigned long long gu64;
#define RLX_AGENT __ATOMIC_RELAXED, __HIP_MEMORY_SCOPE_AGENT
#define LDS_WAIT() asm volatile("s_waitcnt lgkmcnt(0)" ::: "memory")
#define VM_WAIT() asm volatile("s_waitcnt vmcnt(0)" ::: "memory")
__device__ __forceinline__ unsigned long long rt() { return __builtin_amdgcn_s_memrealtime(); }
__device__ __forceinline__ unsigned f2bf(float f) { unsigned u = __builtin_bit_cast(unsigned, f); return (u + 0x7fffu + ((u >> 16) & 1u)) >> 16; }
__device__ __forceinline__ unsigned pk2(float lo, float hi) { return f2bf(lo) | (f2bf(hi) << 16); }

#define XB_TMO      128
#define XB_XCNT(j)  (256  + 64 * (j))
#define XB_XSUB(j)  (1280 + 64 * (j))
#define XB_XGEN(j)  (2304 + 64 * (j))
#define XB_TOP      3328
#define XB_TOPGEN   3392
#define XCD_BAR_WORDS 3456
#define XB_SPIN_CAP (1u << 18)

__device__ __forceinline__ unsigned xb_ld(unsigned* p)              { return __hip_atomic_load(p, __ATOMIC_RELAXED, __HIP_MEMORY_SCOPE_AGENT); }
__device__ __forceinline__ unsigned xb_add(unsigned* p, unsigned v) { return __hip_atomic_fetch_add(p, v, __ATOMIC_RELAXED, __HIP_MEMORY_SCOPE_AGENT); }
__device__ __forceinline__ unsigned xb_xcc_id() { return (unsigned)__builtin_amdgcn_s_getreg((3 << 11) | 20) & 0xFu; }
#define XB_SPIN(cond, bar) do { unsigned _sp = 0; while (cond) { __builtin_amdgcn_s_sleep(1); \
    if ((++_sp & 255u) == 0u) { if (xb_ld(&(bar)[XB_TMO])) break; if (_sp > XB_SPIN_CAP) { atomicAdd(&(bar)[XB_TMO], 1u); break; } } } } while (0)

struct XcdBarrier {
    unsigned* bar; unsigned x;
    volatile LAS unsigned* st;
};

__device__ __forceinline__ XcdBarrier xcd_barrier_post(unsigned* bar, volatile LAS unsigned* st, bool leader) {
    XcdBarrier b; b.bar = bar; b.x = xb_xcc_id(); b.st = st;
    if (leader) (void)xb_add(&bar[XB_XCNT(b.x)], 1u);
    return b;
}
__device__ __forceinline__ void xcd_barrier_complete(unsigned* bar, unsigned x, unsigned& nloc, unsigned& nx) {
    const unsigned G = gridDim.x * gridDim.y * gridDim.z;
    unsigned sum, cnt, mine, sp = 0u;
    for (;;) {
        sum = 0u; cnt = 0u; mine = 0u;
#pragma unroll
        for (unsigned j = 0; j < 16; ++j) { const unsigned c = xb_ld(&bar[XB_XCNT(j)]); sum += c; cnt += (c > 0u) ? 1u : 0u; mine = (j == x) ? c : mine; }
        if (sum == G) break;
        __builtin_amdgcn_s_sleep(1);
        if ((++sp & 255u) == 0u) { if (xb_ld(&bar[XB_TMO])) break; if (sp > XB_SPIN_CAP) { atomicAdd(&bar[XB_TMO], 1u); break; } }
    }
    nloc = mine > 0u ? mine : 1u; nx = cnt > 0u ? cnt : 1u;
}

__device__ __forceinline__ void xcd_barrier(const XcdBarrier& b, bool leader) {
    asm volatile("s_waitcnt vmcnt(0)" ::: "memory");
    __syncthreads();
    if (leader) {
        unsigned* bar = b.bar;
        __builtin_amdgcn_s_waitcnt(0);
        unsigned nloc = b.st[0], nx = b.st[1];
        if (nloc == 0u) { xcd_barrier_complete(bar, b.x, nloc, nx); b.st[0] = nloc; b.st[1] = nx; }
        const unsigned old = xb_add(&bar[XB_XSUB(b.x)], 1u);
        const unsigned gen = old / nloc;
        if (old + 1u == (gen + 1u) * nloc) {
            __builtin_amdgcn_fence(__ATOMIC_RELEASE, "agent");
            asm volatile("s_waitcnt vmcnt(0)" ::: "memory");
            const unsigned og = xb_add(&bar[XB_TOP], 1u);
            const unsigned tg = og / nx;
            if (og + 1u == (tg + 1u) * nx) xb_add(&bar[XB_TOPGEN], 1u);
            else XB_SPIN(xb_ld(&bar[XB_TOPGEN]) == tg, bar);
            __builtin_amdgcn_fence(__ATOMIC_ACQUIRE, "agent");
            xb_add(&bar[XB_XGEN(b.x)], 1u);
            asm volatile("s_waitcnt vmcnt(0)" ::: "memory");
        } else {
            XB_SPIN(xb_ld(&bar[XB_XGEN(b.x)]) == gen, bar);
            __builtin_amdgcn_fence(__ATOMIC_ACQUIRE, "agent");
            asm volatile("s_waitcnt vmcnt(0)" ::: "memory");
        }
    }
    __syncthreads();
}
constexpr int NB = 2, SEQ = 16384, NTOK = NB * SEQ, DM = 1024, NLAYER = 4;
constexpr int PROJW = 4616, PW = 4608;
constexpr int C_MLQK = 0, C_MLV = 1024, C_MLO = 1536, C_MLZ = 2048, C_ATQ = 2560, C_ATK = 3072, C_ATV = 3584, C_ATZ = 4096;
constexpr int SC = 256, NSC = SEQ / SC;
constexpr int NBLK = SEQ / 256;
constexpr float EPS = 1e-6f;
constexpr int NPH = 5;
constexpr int NGP = 1 + NLAYER * NPH;

constexpr size_t MiB = 1u << 20;
constexpr size_t OFF_CTL = 0, CTL_BYTES = 1 * MiB;
constexpr size_t OFF_WIN = 1 * MiB;
constexpr size_t OFF_WOUT = 37 * MiB;
constexpr size_t OFF_XN = 45 * MiB;
constexpr size_t OFF_GATES = 109 * MiB;
constexpr size_t OFF_PROJ = 110 * MiB;
constexpr size_t OFF_Y = 398 * MiB;
constexpr size_t OFF_CT = 462 * MiB;
constexpr size_t OFF_WG = 478 * MiB;
constexpr size_t OFF_SSQ = 479 * MiB;
constexpr size_t OFF_NL = 494 * MiB;
constexpr size_t OFF_KMEAN = 495 * MiB;
constexpr size_t OFF_SEL = 496 * MiB;
constexpr size_t WS_END = 501 * MiB;
constexpr int CW_BAR = 1024;

constexpr int LDS_BYTES = 147456, MISC_OFF = 143360;
constexpr size_t SECSZ = (size_t)NTOK * 512;
enum { S_MQ = 0, S_MK = 1, S_MV = 2, S_MO = 3, S_MZ = 4, S_AQ = 5, S_AK = 6, S_AV = 7, S_AZ = 8 };
__device__ __forceinline__ size_t ml_off(int sec, int b, int hh, int t) { return (size_t)sec * SECSZ + ((size_t)(b * 4 + hh) * SEQ + t) * 128; }
__device__ __forceinline__ size_t at_off(int sec, int b, int h, int t) { return (size_t)sec * SECSZ + ((size_t)(b * 8 + h) * SEQ + t) * 64; }

typedef unsigned u32x2 __attribute__((ext_vector_type(2)));
typedef float f32x2 __attribute__((ext_vector_type(2)));
#define DI __device__ __forceinline__

struct Params {
    const float* x; const float* norm_w; const float* w_in; const float* b_i; const float* b_f; const float* conv_w; const float* conv_b;
    const float* mnorm_w; const float* qn_w; const float* kn_w; const float* w_out;
    float* out; unsigned char* ws; int ph_lo, ph_hi;
};

DI float bf2f(unsigned short h) { return __uint_as_float((unsigned)h << 16); }
DI float bflo(unsigned w) { return __uint_as_float(w << 16); }
DI float bfhi(unsigned w) { return __uint_as_float(w & 0xffff0000u); }
DI float wave_sum(float v) {
#pragma unroll
    for (int o = 1; o < 64; o <<= 1) v += __shfl_xor(v, o);
    return v;
}
DI float wave_max(float v) {
#pragma unroll
    for (int o = 1; o < 64; o <<= 1) v = fmaxf(v, __shfl_xor(v, o));
    return v;
}
DI float scan_add(float v, int lane) {
#pragma unroll
    for (int o = 1; o < 64; o <<= 1) { const float t = __shfl_up(v, o); if (lane >= o) v += t; }
    return v;
}
DI float scan_max(float v, int lane) {
#pragma unroll
    for (int o = 1; o < 64; o <<= 1) { const float t = __shfl_up(v, o); if (lane >= o) v = fmaxf(v, t); }
    return v;
}
DI float silu_f(float v) { return v * __builtin_amdgcn_rcpf(1.0f + __builtin_amdgcn_exp2f(v * -1.4426950408889634f)); }
DI float logsigmoid_f(float f) { return fminf(f, 0.f) - log1pf(__expf(-fabsf(f))); }

struct Ctx { int tid, lane, wave, gw, ngw; LAS unsigned char* lds; };

DI void transpose_item(const float* W, int ldw, int col0, int K, bf16* WT, int row_off, LAS float* scr, int item, int nblk, int lane, const float* rowscale, int perm_lo = 0, int perm_hi = 0) {
    const int kb = item / nblk, nb = item % nblk, k0 = 64 * kb, n0 = 32 * nb;
    float tv[32];
#pragma unroll
    for (int i = 0; i < 32; ++i) { const int kk = 2 * i + (lane >> 5); tv[i] = W[(size_t)(k0 + kk) * ldw + col0 + n0 + (lane & 31)] * (rowscale ? rowscale[k0 + kk] : 1.0f); }
#pragma unroll
    for (int i = 0; i < 32; ++i) { const int kk = 2 * i + (lane >> 5); scr[kk * 33 + (lane & 31)] = tv[i]; }
    LDS_WAIT(); asm volatile("" ::: "memory");
    const int c = lane & 7;
#pragma unroll
    for (int j = 0; j < 4; ++j) { const int n = (lane >> 3) + 8 * j; const LAS float* s = scr + (8 * c) * 33 + n;
        v4u o; o.x = pk2(s[0 * 33], s[1 * 33]); o.y = pk2(s[2 * 33], s[3 * 33]); o.z = pk2(s[4 * 33], s[5 * 33]); o.w = pk2(s[6 * 33], s[7 * 33]);
        int orow = row_off + n0 + n;
        if (orow >= perm_lo && orow < perm_hi) orow = (orow & ~255) + 128 * ((orow & 63) >> 5) + 32 * ((orow & 255) >> 6) + (orow & 31);
        *(v4u*)(WT + (size_t)orow * K + k0 + 8 * c) = o; }
    LDS_WAIT(); asm volatile("" ::: "memory");
}
DI void ph_prologue(const Params& P, const Ctx& C) {
    LAS float* scr = (LAS float*)(C.lds + C.wave * 16384);
    constexpr int IA = 16 * 80, IB = 16 * 64, IO = 16 * 32, IL = IA + IB + IO;
    for (int it = C.gw; it < NLAYER * IL; it += C.ngw) {
        const int l = it / IL; int r = it % IL;
        const float* wi = P.w_in + (size_t)l * DM * PROJW; bf16* wt = (bf16*)(P.ws + OFF_WIN) + (size_t)l * PW * DM;
        if (r < IA) { transpose_item(wi, PROJW, 0, DM, wt, 0, scr, r, 80, C.lane, P.norm_w + l * DM); continue; } r -= IA;
        if (r < IB) { transpose_item(wi, PROJW, 2568, DM, wt, 2560, scr, r, 64, C.lane, P.norm_w + l * DM, C_ATQ, C_ATV); continue; } r -= IB;
        transpose_item(P.w_out + (size_t)l * DM * DM, DM, 0, DM, (bf16*)(P.ws + OFF_WOUT) + (size_t)l * DM * DM, 0, scr, r, 32, C.lane, nullptr);
    }
    bf16* WG = (bf16*)(P.ws + OFF_WG);
    for (int i = (C.gw >> 3) * 512 + C.tid; i < NLAYER * 32 * DM; i += (C.ngw >> 3) * 512) {
        const int k = i & (DM - 1), g = (i >> 10) & 31, l = i >> 15;
        WG[i] = (g < 8) ? (bf16)f2bf(P.w_in[((size_t)l * DM + k) * PROJW + 2560 + g] * P.norm_w[l * DM + k]) : (bf16)0;
    }
    bf16* XB = (bf16*)(P.ws + OFF_XN); float* SSQ = (float*)(P.ws + OFF_SSQ);
    for (int row0 = C.gw * 4; row0 < NTOK; row0 += C.ngw * 4) {
        f32x4 v[4][4];
#pragma unroll
        for (int r = 0; r < 4; ++r)
#pragma unroll
            for (int j = 0; j < 4; ++j) v[r][j] = ((const f32x4*)(P.x + (size_t)(row0 + r) * DM) + C.lane)[64 * j];
#pragma unroll
        for (int r = 0; r < 4; ++r) {
            unsigned long long* o8 = (unsigned long long*)(XB + (size_t)(row0 + r) * DM) + C.lane; float ss = 0.f;
#pragma unroll
            for (int j = 0; j < 4; ++j) { const f32x4 x = v[r][j]; ss += (x.x * x.x + x.y * x.y) + (x.z * x.z + x.w * x.w); o8[64 * j] = (unsigned long long)pk2(x.x, x.y) | ((unsigned long long)pk2(x.z, x.w) << 32); }
            ss = wave_sum(ss);
            if (C.lane < 16) SSQ[(size_t)(row0 + r) * 16 + C.lane] = C.lane == 0 ? ss : 0.f;
        }
    }
}

DI void ph_norm(const Params& P, const Ctx& C, int layer, const float* xin) {
    const int lane = C.lane;
    LAS f32x4* wgl = (LAS f32x4*)C.lds;
    { const float* wl = P.w_in + (size_t)layer * DM * PROJW + 2560;
      for (int i = C.tid; i < 2048; i += 512) wgl[i] = *(const f32x4*)(wl + (size_t)(i >> 1) * PROJW + 4 * (i & 1)); }
    __syncthreads();
    f32x4 nw[4];
#pragma unroll
    for (int j = 0; j < 4; ++j) nw[j] = *(const f32x4*)(P.norm_w + layer * DM + 256 * j + 4 * lane);
    float bias = 0.f; if (lane < 4) bias = P.b_i[layer * 4 + lane]; else if (lane < 8) bias = P.b_f[layer * 4 + lane - 4];
    bf16* XN = (bf16*)(P.ws + OFF_XN); float* G = (float*)(P.ws + OFF_GATES);
    for (int row = C.gw; row < NTOK; row += C.ngw) {
        const f32x4* xr = (const f32x4*)(xin + (size_t)row * DM) + lane;
        f32x4 v[4]; float ss = 0.f;
#pragma unroll
        for (int j = 0; j < 4; ++j) { v[j] = xr[64 * j]; ss += (v[j].x * v[j].x + v[j].y * v[j].y) + (v[j].z * v[j].z + v[j].w * v[j].w); }
        const float rstd = rsqrtf(wave_sum(ss) * (1.f / DM) + EPS);
        f32x4 g0 = {0.f, 0.f, 0.f, 0.f}, g1 = {0.f, 0.f, 0.f, 0.f};
        unsigned long long* o8 = (unsigned long long*)(XN + (size_t)row * DM) + lane;
#pragma unroll
        for (int j = 0; j < 4; ++j) { const f32x4 h = v[j] * rstd * nw[j];
            o8[64 * j] = (unsigned long long)pk2(h.x, h.y) | ((unsigned long long)pk2(h.z, h.w) << 32);
#pragma unroll
            for (int c = 0; c < 4; ++c) { const int k = 256 * j + 4 * lane + c; g0 += wgl[2 * k] * h[c]; g1 += wgl[2 * k + 1] * h[c]; } }
        float gs[8];
#pragma unroll
        for (int i = 0; i < 4; ++i) { gs[i] = wave_sum(g0[i]); gs[4 + i] = wave_sum(g1[i]); }
        float mine = 0.f;
#pragma unroll
        for (int i = 0; i < 8; ++i) if (lane == i) mine = gs[i];
        if (lane < 8) G[(size_t)row * 8 + lane] = mine + bias;
    }
    __syncthreads();
}

DI void ph_conv_qknorm(const Params& P, const Ctx& C, int layer) {
    const int lane = C.lane;
    bf16* PR = (bf16*)(P.ws + OFF_PROJ); bf16* QKC = (bf16*)(P.ws + OFF_XN);
    float qw[8], kw[8];
#pragma unroll
    for (int i = 0; i < 8; ++i) { qw[i] = P.qn_w[layer * 64 + (lane & 7) * 8 + i]; kw[i] = P.kn_w[layer * 64 + (lane & 7) * 8 + i]; }
    for (int tok = C.gw; tok < NTOK; tok += C.ngw) {
        const int t = tok & (SEQ - 1);
#pragma unroll
        for (int it = 0; it < 2; ++it) {
            const int c = it * 512 + lane * 8;
            float a[8];
#pragma unroll
            for (int i = 0; i < 8; ++i) a[i] = P.conv_b[layer * 1024 + c + i];
#pragma unroll
            for (int k = 0; k < 4; ++k) {
                if (t - 3 + k >= 0) {
                    const v4u xv = *(const v4u*)(PR + (size_t)(tok - 3 + k) * PW + C_MLQK + c);
                    const float* w = P.conv_w + ((size_t)layer * 4 + k) * 1024 + c;
                    a[0] += w[0] * bflo(xv.x); a[1] += w[1] * bfhi(xv.x); a[2] += w[2] * bflo(xv.y); a[3] += w[3] * bfhi(xv.y);
                    a[4] += w[4] * bflo(xv.z); a[5] += w[5] * bfhi(xv.z); a[6] += w[6] * bflo(xv.w); a[7] += w[7] * bfhi(xv.w);
                }
            }
            v4u o; o.x = pk2(silu_f(a[0]), silu_f(a[1])); o.y = pk2(silu_f(a[2]), silu_f(a[3])); o.z = pk2(silu_f(a[4]), silu_f(a[5])); o.w = pk2(silu_f(a[6]), silu_f(a[7]));
            *(v4u*)(QKC + (size_t)tok * 1024 + c) = o;
        }
#pragma unroll
        for (int which = 0; which < 2; ++which) {
            bf16* p = PR + (size_t)tok * PW + (which ? C_ATK : C_ATQ) + lane * 8;
            const v4u xv = *(const v4u*)p;
            float v[8] = {bflo(xv.x), bfhi(xv.x), bflo(xv.y), bfhi(xv.y), bflo(xv.z), bfhi(xv.z), bflo(xv.w), bfhi(xv.w)};
            float ss = 0.f;
#pragma unroll
            for (int i = 0; i < 8; ++i) ss += v[i] * v[i];
            ss += __shfl_xor(ss, 1); ss += __shfl_xor(ss, 2); ss += __shfl_xor(ss, 4);
            const float r = rsqrtf(ss * (1.f / 64.f) + EPS);
#pragma unroll
            for (int i = 0; i < 8; ++i) v[i] = v[i] * r * (which ? kw[i] : qw[i]);
            v4u o; o.x = pk2(v[0], v[1]); o.y = pk2(v[2], v[3]); o.z = pk2(v[4], v[5]); o.w = pk2(v[6], v[7]);
            *(v4u*)p = o;
        }
    }
}

DI void gate_scalars(const float* G, int tok0, int hh, int lane, float (&bb)[4], float (&aa)[4]) {
    float lf[4], ii[4];
#pragma unroll
    for (int j = 0; j < 4; ++j) { const float* g = G + (size_t)(tok0 + 4 * lane + j) * 8; ii[j] = g[hh]; lf[j] = logsigmoid_f(g[4 + hh]); }
    lf[1] += lf[0]; lf[2] += lf[1]; lf[3] += lf[2];
    const float incl = scan_add(lf[3], lane), excl = incl - lf[3];
#pragma unroll
    for (int j = 0; j < 4; ++j) { bb[j] = excl + lf[j]; aa[j] = ii[j] - bb[j]; }
}

DI void ph_cloc_kmean(const Params& P, const Ctx& C) {
    const int lane = C.lane;
    const bf16* PR = (const bf16*)(P.ws + OFF_PROJ); const bf16* QKC = (const bf16*)(P.ws + OFF_XN); const float* G = (const float*)(P.ws + OFF_GATES);
    float* CT = (float*)(P.ws + OFF_CT); float* NL = (float*)(P.ws + OFF_NL); float* MLOC = NL + 8 * 64 * 128; float* BLAST = MLOC + 512;
    LAS float* wts = (LAS float*)(C.lds + C.wave * 16384);
    for (int it = C.gw; it < 8 * NSC * 16; it += C.ngw) {
        const int eg = it & 15, unit = it >> 4, sc = unit & 63, bh = unit >> 6, b = bh >> 2, hh = bh & 3;
        const int tok0 = b * SEQ + sc * SC;
        float bb[4], aa[4]; gate_scalars(G, tok0, hh, lane, bb, aa);
        const float A = wave_max(fmaxf(fmaxf(aa[0], aa[1]), fmaxf(aa[2], aa[3])));
        const float blast = __shfl(bb[3], 63);
#pragma unroll
        for (int j = 0; j < 4; ++j) wts[4 * lane + j] = __expf(aa[j] - A);
        LDS_WAIT(); asm volatile("" ::: "memory");
        float acc[8][2]; float nacc[2] = {0.f, 0.f};
#pragma unroll
        for (int e = 0; e < 8; ++e) { acc[e][0] = 0.f; acc[e][1] = 0.f; }
        for (int t = 0; t < SC; ++t) {
            const unsigned kk = *(const unsigned*)(QKC + (size_t)(tok0 + t) * 1024 + 512 + hh * 128 + 2 * lane);
            const v4u vv = *(const v4u*)(PR + (size_t)(tok0 + t) * PW + C_MLV + hh * 128 + eg * 8);
            const float w = wts[t]; const float k0 = bflo(kk) * w, k1 = bfhi(kk) * w;
            const float ve[8] = {bflo(vv.x), bfhi(vv.x), bflo(vv.y), bfhi(vv.y), bflo(vv.z), bfhi(vv.z), bflo(vv.w), bfhi(vv.w)};
#pragma unroll
            for (int e = 0; e < 8; ++e) { acc[e][0] += k0 * ve[e]; acc[e][1] += k1 * ve[e]; }
            nacc[0] += k0; nacc[1] += k1;
        }
#pragma unroll
        for (int e = 0; e < 8; ++e) *(f32x2*)(CT + ((size_t)unit * 128 + eg * 8 + e) * 128 + 2 * lane) = (f32x2){acc[e][0], acc[e][1]};
        if (eg == 0) { *(f32x2*)(NL + (size_t)unit * 128 + 2 * lane) = (f32x2){nacc[0], nacc[1]}; if (lane == 0) { MLOC[unit] = blast + A; BLAST[unit] = blast; } }
        LDS_WAIT(); asm volatile("" ::: "memory");
    }
    float* KM = (float*)(P.ws + OFF_KMEAN);
    for (int it = C.gw; it < NB * 8 * NBLK; it += C.ngw) {
        const int n = it & 63, h = (it >> 6) & 7, b = it >> 9;
        const bf16* kp = PR + (size_t)(b * SEQ + n * 256) * PW + C_ATK + h * 64 + lane;
        float s = 0.f;
        for (int r = 0; r < 256; ++r) s += bf2f(kp[(size_t)r * PW]);
        KM[(size_t)it * 64 + lane] = s * (1.f / 256.f);
    }
}

template <bool DO_SCAN, bool DO_SEL> DI void ph_scan_select(const Params& P, const Ctx& C) {
    float* CT = (float*)(P.ws + OFF_CT); float* NL = (float*)(P.ws + OFF_NL); float* MLOC = NL + 8 * 64 * 128; float* BLAST = MLOC + 512; float* MPREV = BLAST + 512;
    const int gt = (C.gw >> 3) * 512 + C.tid, ngt = (C.ngw >> 3) * 512;
    if constexpr (DO_SCAN)
    for (int idx = gt; idx < 8 * (16384 + 128); idx += ngt) {
        const int bh = idx / 16512, r = idx % 16512;
        float* ptr; int stride;
        if (r < 16384) { ptr = CT + (size_t)bh * 64 * 16384 + r; stride = 16384; } else { ptr = NL + (size_t)bh * 64 * 128 + (r - 16384); stride = 128; }
        float c = 0.f, m = 0.f;
        for (int s0 = 0; s0 < NSC; s0 += 8) {
            float cl[8];
#pragma unroll
            for (int i = 0; i < 8; ++i) cl[i] = ptr[(size_t)(s0 + i) * stride];
#pragma unroll
            for (int i = 0; i < 8; ++i) {
                const float ml = MLOC[bh * 64 + s0 + i], bl = BLAST[bh * 64 + s0 + i];
                ptr[(size_t)(s0 + i) * stride] = c;
                if (r == 0) MPREV[bh * 64 + s0 + i] = m;
                const float mn = fmaxf(bl + m, ml);
                c = __expf(bl + m - mn) * c + __expf(ml - mn) * cl[i];
                m = mn;
            }
        }
    }
    const bf16* PR = (const bf16*)(P.ws + OFF_PROJ); const float* KM = (const float*)(P.ws + OFF_KMEAN); int* SEL = (int*)(P.ws + OFF_SEL);
    if constexpr (DO_SEL)
    for (int idx = gt; idx < NTOK * 8; idx += ngt) {
        const int tok = idx >> 3, h = idx & 7, b = tok >> 14, t = tok & (SEQ - 1), j = t >> 8;
        float q[64];
        const v4u* qp = (const v4u*)(PR + (size_t)tok * PW + C_ATQ + h * 64);
#pragma unroll
        for (int i = 0; i < 8; ++i) { const v4u w = qp[i]; q[8 * i] = bflo(w.x); q[8 * i + 1] = bfhi(w.x); q[8 * i + 2] = bflo(w.y); q[8 * i + 3] = bfhi(w.y); q[8 * i + 4] = bflo(w.z); q[8 * i + 5] = bfhi(w.z); q[8 * i + 6] = bflo(w.w); q[8 * i + 7] = bfhi(w.w); }
        float v0 = -INFINITY, v1 = -INFINITY, v2 = -INFINITY; int i0 = -1, i1 = -1, i2 = -1;
        const float* km = KM + (size_t)((b * 8 + h) * 64) * 64;
        for (int n = 0; n < j; ++n) {
            const f32x4* kp = (const f32x4*)(km + n * 64);
            float d = 0.f;
#pragma unroll
            for (int i = 0; i < 16; ++i) { const f32x4 kv = kp[i]; d += q[4 * i] * kv.x + q[4 * i + 1] * kv.y + q[4 * i + 2] * kv.z + q[4 * i + 3] * kv.w; }
            if (d > v0) { v2 = v1; i2 = i1; v1 = v0; i1 = i0; v0 = d; i0 = n; }
            else if (d > v1) { v2 = v1; i2 = i1; v1 = d; i1 = n; }
            else if (d > v2) { v2 = d; i2 = n; }
        }
        *(int4*)(SEL + (size_t)idx * 4) = make_int4(i0, i1, i2, -1);
    }
}

template <bool DO_ML, bool DO_AT> DI void ph_mixers(const Params& P, const Ctx& C, int layer) {
    const int lane = C.lane;
    const bf16* PR = (const bf16*)(P.ws + OFF_PROJ); const bf16* QKC = (const bf16*)(P.ws + OFF_XN); const float* G = (const float*)(P.ws + OFF_GATES);
    const float* CT = (const float*)(P.ws + OFF_CT); const float* NL = (const float*)(P.ws + OFF_NL); const float* MPREV = NL + 8 * 64 * 128 + 1024;
    bf16* Y = (bf16*)(P.ws + OFF_Y);
    LAS float* sa = (LAS float*)(C.lds + C.wave * 16384);
    LAS float* sM = sa + 256;
    LAS float* sb = sa + 512;
    LAS float* sq = sa + 768;
    if constexpr (DO_ML)
    for (int it = C.gw; it < 8 * NSC * 8; it += C.ngw) {
        const int tg = it & 7, unit = it >> 3, sc = unit & 63, bh = unit >> 6, b = bh >> 2, hh = bh & 3;
        const int tok0 = b * SEQ + sc * SC;
        float bb[4], aa[4]; gate_scalars(G, tok0, hh, lane, bb, aa);
        const float mprev = MPREV[unit];
        float cm[4]; cm[0] = aa[0]; cm[1] = fmaxf(cm[0], aa[1]); cm[2] = fmaxf(cm[1], aa[2]); cm[3] = fmaxf(cm[2], aa[3]);
        const float incl = scan_max(cm[3], lane); float excl = __shfl_up(incl, 1); if (lane == 0) excl = -INFINITY;
#pragma unroll
        for (int j = 0; j < 4; ++j) { sa[4 * lane + j] = aa[j]; sb[4 * lane + j] = bb[j]; sM[4 * lane + j] = fmaxf(mprev, fmaxf(excl, cm[j])); }
        LDS_WAIT(); asm volatile("" ::: "memory");
        const float* ct = CT + (size_t)unit * 16384; const f32x2 nprev = *(const f32x2*)(NL + (size_t)unit * 128 + 2 * lane);
        const f32x2 mw = *(const f32x2*)(P.mnorm_w + layer * 512 + hh * 128 + 2 * lane);
        for (int tl = tg * 32; tl < tg * 32 + 32; ++tl) {
            const int tok = tok0 + tl;
            const unsigned qq = *(const unsigned*)(QKC + (size_t)tok * 1024 + hh * 128 + 2 * lane);
            const float q0 = bflo(qq) * 0.08838834764831845f, q1 = bfhi(qq) * 0.08838834764831845f;
            sq[2 * lane] = q0; sq[2 * lane + 1] = q1;
            const float Mt = sM[tl], bt = sb[tl];
            float n0 = 0.f, n1 = 0.f, den = 0.f;
            for (int s = 0; s <= tl; ++s) {
                const unsigned kk = *(const unsigned*)(QKC + (size_t)(tok0 + s) * 1024 + 512 + hh * 128 + 2 * lane);
                const unsigned vv = *(const unsigned*)(PR + (size_t)(tok0 + s) * PW + C_MLV + hh * 128 + 2 * lane);
                const float dot = wave_sum(q0 * bflo(kk) + q1 * bfhi(kk));
                const float sv = dot * __expf(sa[s] - Mt);
                den += sv; n0 += sv * bflo(vv); n1 += sv * bfhi(vv);
            }
            LDS_WAIT(); asm volatile("" ::: "memory");
            float c0 = 0.f, c1 = 0.f;
            const f32x4* r0 = (const f32x4*)(ct + (size_t)(2 * lane) * 128); const f32x4* r1 = (const f32x4*)(ct + (size_t)(2 * lane + 1) * 128);
#pragma unroll 8
            for (int d4 = 0; d4 < 32; ++d4) { const f32x4 a = r0[d4], bq = r1[d4]; const float qa = sq[4 * d4], qb = sq[4 * d4 + 1], qc = sq[4 * d4 + 2], qd = sq[4 * d4 + 3];
                c0 += qa * a.x + qb * a.y + qc * a.z + qd * a.w; c1 += qa * bq.x + qb * bq.y + qc * bq.z + qd * bq.w; }
            const float qn = wave_sum(q0 * nprev.x + q1 * nprev.y);
            const float si = __expf(mprev - Mt);
            n0 += si * c0; n1 += si * c1; den += si * qn;
            const float dn = fmaxf(fabsf(den), __expf(-(bt + Mt)));
            const unsigned oo = *(const unsigned*)(PR + (size_t)tok * PW + C_MLO + hh * 128 + 2 * lane);
            const unsigned zz = *(const unsigned*)(PR + (size_t)tok * PW + C_MLZ + hh * 128 + 2 * lane);
            const float h0 = bflo(oo) * n0 / dn, h1 = bfhi(oo) * n1 / dn;
            const float r = rsqrtf(wave_sum(h0 * h0 + h1 * h1) * (1.f / 128.f) + EPS);
            *(unsigned*)(Y + (size_t)tok * 1024 + hh * 128 + 2 * lane) = pk2(h0 * r * mw.x * bflo(zz), h1 * r * mw.y * bfhi(zz));
            LDS_WAIT(); asm volatile("" ::: "memory");
        }
    }
    const int* SEL = (const int*)(P.ws + OFF_SEL);
    if constexpr (DO_AT)
    for (int it = C.gw; it < NTOK * 8; it += C.ngw) {
        const int tok = it >> 3, h = it & 7, b = tok >> 14, t = tok & (SEQ - 1), j = t >> 8;
        const float slope = exp2f(-(float)(h + 1));
        float q[64];
        const v4u* qp = (const v4u*)(PR + (size_t)tok * PW + C_ATQ + h * 64);
#pragma unroll
        for (int i = 0; i < 8; ++i) { const v4u w = qp[i]; q[8 * i] = bflo(w.x); q[8 * i + 1] = bfhi(w.x); q[8 * i + 2] = bflo(w.y); q[8 * i + 3] = bfhi(w.y); q[8 * i + 4] = bflo(w.z); q[8 * i + 5] = bfhi(w.z); q[8 * i + 6] = bflo(w.w); q[8 * i + 7] = bfhi(w.w); }
        const int4 sel = *(const int4*)(SEL + (size_t)it * 4);
        float m = -1e30f, l = 0.f, o = 0.f;
        for (int bi = 0; bi < 4; ++bi) {
            const int n = bi == 0 ? sel.x : bi == 1 ? sel.y : bi == 2 ? sel.z : j;
            if (n < 0) continue;
            const int nst = (bi == 3) ? ((t & 255) >> 6) + 1 : 4;
            for (int st = 0; st < nst; ++st) {
                const int s = n * 256 + st * 64 + lane;
                const v4u* kp = (const v4u*)(PR + (size_t)(b * SEQ + s) * PW + C_ATK + h * 64);
                float d = 0.f;
#pragma unroll
                for (int i = 0; i < 8; ++i) { const v4u w = kp[i]; d += q[8 * i] * bflo(w.x) + q[8 * i + 1] * bfhi(w.x) + q[8 * i + 2] * bflo(w.y) + q[8 * i + 3] * bfhi(w.y) + q[8 * i + 4] * bflo(w.z) + q[8 * i + 5] * bfhi(w.z) + q[8 * i + 6] * bflo(w.w) + q[8 * i + 7] * bfhi(w.w); }
                float scv = d * 0.125f - slope * (float)(t - s);
                if (s > t) scv = -INFINITY;
                const float mn = fmaxf(m, wave_max(scv));
                const float p = __expf(scv - mn), corr = __expf(m - mn);
                l = l * corr + wave_sum(p); o *= corr; m = mn;
                const bf16* vp = PR + (size_t)(b * SEQ + n * 256 + st * 64) * PW + C_ATV + h * 64 + lane;
#pragma unroll 8
                for (int kk = 0; kk < 64; ++kk) o += __shfl(p, kk) * bf2f(vp[(size_t)kk * PW]);
            }
        }
        const float z = bf2f(PR[(size_t)tok * PW + C_ATZ + h * 64 + lane]);
        Y[(size_t)tok * 1024 + 512 + h * 64 + lane] = (bf16)f2bf(o / l * z);
    }
}

typedef float f32x16 __attribute__((ext_vector_type(16)));
typedef short s16x4 __attribute__((ext_vector_type(4)));
typedef __bf16 bf16x2_t __attribute__((ext_vector_type(2)));
#define MFMA32(a, b, c) __builtin_amdgcn_mfma_f32_32x32x16_bf16((a), (b), (c), 0, 0, 0)
constexpr int LDS_IMGK = 0, LDS_IMGV = 65536, LDS_SCAL = 131072;
constexpr float ML_SCALE = 0.08838834764831845f;

DI int crow(int i, int h) { return (i & 3) + 8 * (i >> 2) + 4 * h; }
DI unsigned cvtpk(float lo, float hi) { f32x2 v = {lo, hi}; bf16x2_t b = __builtin_convertvector(v, bf16x2_t); return __builtin_bit_cast(unsigned, b); }
DI bf16x8 pack8(float a0, float a1, float a2, float a3, float a4, float a5, float a6, float a7) { v4u w; w.x = cvtpk(a0, a1); w.y = cvtpk(a2, a3); w.z = cvtpk(a4, a5); w.w = cvtpk(a6, a7); return __builtin_bit_cast(bf16x8, w); }
DI int img_off(int row, int ch) { return 256 * row + 16 * (ch ^ (((row & 3) << 2) | ((row >> 2) & 3))); }
DI s16x4 tr_read(const LAS unsigned char* p) { return __builtin_bit_cast(s16x4, __builtin_amdgcn_ds_read_tr16_b64_v4i16((LAS s16x4*)p)); }
DI bf16x8 tr_frag(const LAS unsigned char* img, int lane, int c, int rlo, int rhi) {
    const int blk = (lane >> 4) & 1, q = (lane & 15) >> 2, p = lane & 3, ch = 4 * c + 2 * blk + (p >> 1), sub = 8 * (p & 1);
    const s16x4 lo = tr_read(img + img_off(rlo + q, ch) + sub), hi = tr_read(img + img_off(rhi + q, ch) + sub);
    return __builtin_shufflevector(lo, hi, 0, 1, 2, 3, 4, 5, 6, 7);
}
template <bool SCALE> DI void stage_tile(LAS unsigned char* img, const bf16* g, int pitch, int tid, const LAS float* wrow) {
    v4u v[8];
#pragma unroll
    for (int i = 0; i < 8; ++i) { const int id = tid + 512 * i, row = id >> 4, ch = id & 15; v[i] = *(const v4u*)(g + (size_t)row * pitch + ch * 8); }
#pragma unroll
    for (int i = 0; i < 8; ++i) { const int id = tid + 512 * i, row = id >> 4, ch = id & 15; v4u x = v[i];
        if (SCALE) { const float w = wrow[row]; x.x = cvtpk(bflo(x.x) * w, bfhi(x.x) * w); x.y = cvtpk(bflo(x.y) * w, bfhi(x.y) * w); x.z = cvtpk(bflo(x.z) * w, bfhi(x.z) * w); x.w = cvtpk(bflo(x.w) * w, bfhi(x.w) * w); }
        *(LAS v4u*)(img + img_off(row, ch)) = x; }
}

template <bool SCALE> DI void stage_tile_conv(LAS unsigned char* img, const bf16* graw, const float* cw, const float* cb, bool first, int tid, const LAS float* wrow) {
    const int ch = tid & 15, r0 = (tid >> 4) * 8;
    float w[4][8], bias[8];
#pragma unroll
    for (int k = 0; k < 4; ++k) { const f32x4 a = *(const f32x4*)(cw + k * 1024 + ch * 8), b = *(const f32x4*)(cw + k * 1024 + ch * 8 + 4);
        w[k][0] = a.x; w[k][1] = a.y; w[k][2] = a.z; w[k][3] = a.w; w[k][4] = b.x; w[k][5] = b.y; w[k][6] = b.z; w[k][7] = b.w; }
    { const f32x4 a = *(const f32x4*)(cb + ch * 8), b = *(const f32x4*)(cb + ch * 8 + 4); bias[0] = a.x; bias[1] = a.y; bias[2] = a.z; bias[3] = a.w; bias[4] = b.x; bias[5] = b.y; bias[6] = b.z; bias[7] = b.w; }
    const bf16* gp = graw + (size_t)r0 * 128 + ch * 8;
    v4u x[7];
#pragma unroll
    for (int i = 0; i < 3; ++i) { const int rr = r0 - 3 + i; if (first && rr < 0) x[i] = (v4u){0u, 0u, 0u, 0u}; else x[i] = *(const v4u*)(gp + (ptrdiff_t)(i - 3) * 128); }
#pragma unroll 1
    for (int half = 0; half < 2; ++half) {
#pragma unroll
        for (int i = 0; i < 4; ++i) x[3 + i] = *(const v4u*)(gp + (ptrdiff_t)(4 * half + i) * 128);
#pragma unroll
        for (int i = 0; i < 4; ++i) {
            float a[8];
#pragma unroll
            for (int c = 0; c < 8; ++c) a[c] = bias[c];
#pragma unroll
            for (int k = 0; k < 4; ++k) { const v4u xv = x[i + k];
                a[0] += w[k][0] * bflo(xv.x); a[1] += w[k][1] * bfhi(xv.x); a[2] += w[k][2] * bflo(xv.y); a[3] += w[k][3] * bfhi(xv.y);
                a[4] += w[k][4] * bflo(xv.z); a[5] += w[k][5] * bfhi(xv.z); a[6] += w[k][6] * bflo(xv.w); a[7] += w[k][7] * bfhi(xv.w); }
            const int row = r0 + 4 * half + i; const float sc = SCALE ? wrow[row] : 1.0f;
            v4u o; o.x = cvtpk(silu_f(a[0]) * sc, silu_f(a[1]) * sc); o.y = cvtpk(silu_f(a[2]) * sc, silu_f(a[3]) * sc); o.z = cvtpk(silu_f(a[4]) * sc, silu_f(a[5]) * sc); o.w = cvtpk(silu_f(a[6]) * sc, silu_f(a[7]) * sc);
            *(LAS v4u*)(img + img_off(row, ch)) = o;
        }
        x[0] = x[4]; x[1] = x[5]; x[2] = x[6];
    }
}

DI void stage_tile_load(v4u (&v)[8], const bf16* g, int pitch, int tid) {
#pragma unroll
    for (int i = 0; i < 8; ++i) { const int id = tid + 512 * i, row = id >> 4, ch = id & 15; v[i] = *(const v4u*)(g + (size_t)row * pitch + ch * 8); }
}
DI void stage_tile_store(LAS unsigned char* img, const v4u (&v)[8], int tid) {
#pragma unroll
    for (int i = 0; i < 8; ++i) { const int id = tid + 512 * i, row = id >> 4, ch = id & 15; *(LAS v4u*)(img + img_off(row, ch)) = v[i]; }
}
DI void stage_conv_load(v4u (&x)[11], const bf16* graw, bool first, int tid) {
    const int ch = tid & 15, r0 = (tid >> 4) * 8; const bf16* gp = graw + (size_t)r0 * 128 + ch * 8;
#pragma unroll
    for (int i = 0; i < 11; ++i) { const int rr = r0 - 3 + i; if (first && rr < 0) x[i] = (v4u){0u, 0u, 0u, 0u}; else x[i] = *(const v4u*)(gp + (ptrdiff_t)(i - 3) * 128); }
}
DI void stage_conv_store(LAS unsigned char* img, const v4u (&x)[11], const float* cw, const float* cb, int tid) {
    const int ch = tid & 15, r0 = (tid >> 4) * 8;
    float w[4][8], bias[8];
#pragma unroll
    for (int k = 0; k < 4; ++k) { const f32x4 a = *(const f32x4*)(cw + k * 1024 + ch * 8), b = *(const f32x4*)(cw + k * 1024 + ch * 8 + 4);
        w[k][0] = a.x; w[k][1] = a.y; w[k][2] = a.z; w[k][3] = a.w; w[k][4] = b.x; w[k][5] = b.y; w[k][6] = b.z; w[k][7] = b.w; }
    { const f32x4 a = *(const f32x4*)(cb + ch * 8), b = *(const f32x4*)(cb + ch * 8 + 4); bias[0] = a.x; bias[1] = a.y; bias[2] = a.z; bias[3] = a.w; bias[4] = b.x; bias[5] = b.y; bias[6] = b.z; bias[7] = b.w; }
#pragma unroll
    for (int i = 0; i < 8; ++i) {
        float a[8];
#pragma unroll
        for (int c = 0; c < 8; ++c) a[c] = bias[c];
#pragma unroll
        for (int k = 0; k < 4; ++k) { const v4u xv = x[i + k];
            a[0] += w[k][0] * bflo(xv.x); a[1] += w[k][1] * bfhi(xv.x); a[2] += w[k][2] * bflo(xv.y); a[3] += w[k][3] * bfhi(xv.y);
            a[4] += w[k][4] * bflo(xv.z); a[5] += w[k][5] * bfhi(xv.z); a[6] += w[k][6] * bflo(xv.w); a[7] += w[k][7] * bfhi(xv.w); }
        v4u o; o.x = cvtpk(silu_f(a[0]), silu_f(a[1])); o.y = cvtpk(silu_f(a[2]), silu_f(a[3])); o.z = cvtpk(silu_f(a[4]), silu_f(a[5])); o.w = cvtpk(silu_f(a[6]), silu_f(a[7]));
        *(LAS v4u*)(img + img_off(r0 + i, ch)) = o;
    }
}

typedef float f32x4m __attribute__((ext_vector_type(4)));
DI void ph_gates_mfma(const Params& P, const Ctx& C, int layer) {
    const int wave = C.wave, bid = C.gw >> 3, nb = C.ngw >> 3;
    const bf16* XB = (const bf16*)(P.ws + OFF_XN); const bf16* WG = (const bf16*)(P.ws + OFF_WG) + (size_t)layer * 32 * DM; const float* SSQ = (const float*)(P.ws + OFF_SSQ); float* G = (float*)(P.ws + OFF_GATES);
    { const int tid = C.tid;
#pragma unroll
      for (int i = 0; i < 4; ++i) { const int id = tid + 512 * i, row = id >> 7, ch = id & 127; *(LAS v4u*)(C.lds + row * 2048 + 16 * (ch ^ row)) = *(const v4u*)(WG + (size_t)row * DM + ch * 8); } }
    __syncthreads();
    for (int unit = bid; unit < NTOK / 128; unit += nb) {
        int lane = C.lane; asm volatile("" : "+v"(lane));
        const int r16 = lane & 15, kq = lane >> 4, tokb = unit * 128 + 16 * wave;
        const bf16* ap = XB + (size_t)(tokb + r16) * DM + 8 * kq;
        f32x4m acc = {0.f, 0.f, 0.f, 0.f};
#pragma unroll 16
        for (int ks = 0; ks < 32; ++ks) {
            const bf16x8 a = *(const bf16x8*)(ap + 32 * ks);
            const bf16x8 bfr = *(const LAS bf16x8*)(C.lds + r16 * 2048 + 16 * ((4 * ks + kq) ^ r16));
            acc = __builtin_amdgcn_mfma_f32_16x16x32_bf16(a, bfr, acc, 0, 0, 0);
        }
        const f32x4* sp = (const f32x4*)(SSQ + (size_t)(tokb + r16) * 16); const f32x4 s0 = sp[0], s1 = sp[1], s2 = sp[2], s3 = sp[3];
        const float tt = ((s0[0] + s0[1]) + (s0[2] + s0[3])) + ((s1[0] + s1[1]) + (s1[2] + s1[3])) + ((s2[0] + s2[1]) + (s2[2] + s2[3])) + ((s3[0] + s3[1]) + (s3[2] + s3[3]));
        const float rstd = rsqrtf(tt * (1.0f / 1024.0f) + EPS);
        float bias = 0.f; if (r16 < 4) bias = P.b_i[layer * 4 + r16]; else if (r16 < 8) bias = P.b_f[layer * 4 + r16 - 4];
#pragma unroll
        for (int i = 0; i < 4; ++i) { const int row = 4 * kq + i; const float rr = __shfl(rstd, row); if (r16 < 8) G[(size_t)(tokb + row) * 8 + r16] = acc[i] * rr + bias; }
    }
    __syncthreads();
}

DI void ph_cloc_mfma(const Params& P, const Ctx& C, int layer) {
    const int wave = C.wave, bid = C.gw >> 3, nb = C.ngw >> 3;
    const bf16* PR = (const bf16*)(P.ws + OFF_PROJ); const float* G = (const float*)(P.ws + OFF_GATES);
    bf16* CT = (bf16*)(P.ws + OFF_CT); float* NL = (float*)(P.ws + OFF_NL); float* MLOC = NL + 8 * 64 * 128; float* BLAST = MLOC + 512;
    LAS unsigned char* imgK = C.lds + LDS_IMGK; LAS unsigned char* imgV = C.lds + LDS_IMGV; LAS float* sw = (LAS float*)(C.lds + LDS_SCAL) + 768;
    for (int unit = bid; unit < 8 * NSC; unit += nb) {
        int lane = C.lane; asm volatile("" : "+v"(lane));
        const int tid = wave * 64 + lane, r32 = lane & 31, h = lane >> 5;
        const int sc = unit & 63, bh = unit >> 6, b = bh >> 2, hh = bh & 3, tok0 = b * SEQ + sc * SC;
        __syncthreads();
        if (wave == 0) {
            float bb[4], aa[4]; gate_scalars(G, tok0, hh, lane, bb, aa);
            const float A = wave_max(fmaxf(fmaxf(aa[0], aa[1]), fmaxf(aa[2], aa[3])));
            const float blast = __shfl(bb[3], 63);
#pragma unroll
            for (int j = 0; j < 4; ++j) sw[4 * lane + j] = __expf(aa[j] - A);
            if (lane == 0) { MLOC[unit] = blast + A; BLAST[unit] = blast; }
        }
        __syncthreads();
        stage_tile_conv<true>(imgK, PR + ml_off(S_MK, b, hh, sc * SC), P.conv_w + (size_t)layer * 4096 + 512 + hh * 128, P.conv_b + layer * 1024 + 512 + hh * 128, sc == 0, tid, sw);
        stage_tile<false>(imgV, PR + ml_off(S_MV, b, hh, sc * SC), 128, tid, nullptr);
        __syncthreads();
        const int eb = wave >> 1, db0 = 2 * (wave & 1);
        f32x16 acc0 = {}, acc1 = {}, accn = {};
        bf16x8 ones; { const short o = (r32 == 0) ? (short)0x3F80 : (short)0; ones = (bf16x8){o, o, o, o, o, o, o, o}; }
#pragma unroll 4
        for (int ks = 0; ks < 16; ++ks) {
            const int rlo = 16 * ks + 8 * h, rhi = rlo + 4;
            const bf16x8 A = tr_frag(imgV, lane, eb, rlo, rhi);
            const bf16x8 B0 = tr_frag(imgK, lane, db0, rlo, rhi), B1 = tr_frag(imgK, lane, db0 + 1, rlo, rhi);
            acc0 = MFMA32(A, B0, acc0); acc1 = MFMA32(A, B1, acc1);
            if (wave < 4) { const bf16x8 Bn = tr_frag(imgK, lane, wave, rlo, rhi); accn = MFMA32(ones, Bn, accn); }
        }
        bf16* ct = CT + (size_t)unit * 16384;
#pragma unroll
        for (int i = 0; i < 16; ++i) { const int e = 32 * eb + crow(i, h);
            ct[e * 128 + 32 * db0 + r32] = (bf16)f2bf(acc0[i]); ct[e * 128 + 32 * (db0 + 1) + r32] = (bf16)f2bf(acc1[i]); }
        if (wave < 4 && h == 0) NL[(size_t)unit * 128 + 32 * wave + r32] = accn[0];
    }
}

DI void ph_scan_bf16(const Params& P, const Ctx& C) {
    unsigned* CT = (unsigned*)(P.ws + OFF_CT); float* NL = (float*)(P.ws + OFF_NL); const float* MLOC = NL + 8 * 64 * 128; const float* BLAST = MLOC + 512; float* MPREV = NL + 8 * 64 * 128 + 1024;
    const int gt = (C.gw >> 3) * 512 + C.tid, ngt = (C.ngw >> 3) * 512;
    for (int idx = gt; idx < 8 * 8192; idx += ngt) {
        const int bh = __builtin_amdgcn_readfirstlane(idx >> 13), r = idx & 8191;
        unsigned* ptr = CT + (size_t)bh * 64 * 8192 + r;
        float c0 = 0.f, c1 = 0.f, m = 0.f;
        for (int s0 = 0; s0 < NSC; s0 += 8) {
            unsigned cl[8];
#pragma unroll
            for (int i = 0; i < 8; ++i) cl[i] = ptr[(size_t)(s0 + i) * 8192];
#pragma unroll
            for (int i = 0; i < 8; ++i) {
                const float ml = MLOC[bh * 64 + s0 + i], bl = BLAST[bh * 64 + s0 + i];
                ptr[(size_t)(s0 + i) * 8192] = cvtpk(c0, c1);
                const float mn = fmaxf(bl + m, ml), sp = __expf(bl + m - mn), sl = __expf(ml - mn);
                c0 = sp * c0 + sl * bflo(cl[i]); c1 = sp * c1 + sl * bfhi(cl[i]); m = mn;
            }
        }
    }
    if (C.tid < 8) {
        for (int idx = ((C.ngw >> 3) - 1 - (C.gw >> 3)) * 8 + C.tid; idx < 8 * 128; idx += (C.ngw >> 3) * 8) {
            const int bh = __builtin_amdgcn_readfirstlane(idx >> 7), r = idx & 127;
            float* ptr = NL + (size_t)bh * 64 * 128 + r;
            float c = 0.f, m = 0.f;
            for (int s0 = 0; s0 < NSC; s0 += 16) {
                float cl[16], ml[16], bl[16];
#pragma unroll
                for (int i = 0; i < 16; ++i) { cl[i] = ptr[(s0 + i) * 128]; ml[i] = MLOC[bh * 64 + s0 + i]; bl[i] = BLAST[bh * 64 + s0 + i]; }
#pragma unroll
                for (int i = 0; i < 16; ++i) {
                    ptr[(s0 + i) * 128] = c; if (r == 0) MPREV[bh * 64 + s0 + i] = m;
                    const float mn = fmaxf(bl[i] + m, ml[i]);
                    c = __expf(bl[i] + m - mn) * c + __expf(ml[i] - mn) * cl[i]; m = mn;
                }
            }
        }
    }
}

DI void ph_mlstm_out_mfma(const Params& P, const Ctx& C, int layer) {
    const int wave = C.wave, bid = C.gw >> 3, nb = C.ngw >> 3;
    const bf16* PR = (const bf16*)(P.ws + OFF_PROJ); const float* G = (const float*)(P.ws + OFF_GATES);
    const bf16* CT = (const bf16*)(P.ws + OFF_CT); const float* NL = (const float*)(P.ws + OFF_NL); const float* MPREV = NL + 8 * 64 * 128 + 1024;
    bf16* Y = (bf16*)(P.ws + OFF_Y);
    LAS unsigned char* imgK = C.lds + LDS_IMGK; LAS unsigned char* imgV = C.lds + LDS_IMGV;
    LAS float* sa = (LAS float*)(C.lds + LDS_SCAL); LAS float* sb = sa + 256; LAS float* sM = sa + 512;
    TS_DECL;
    for (int unit = bid; unit < 8 * NSC; unit += nb) {
        TS_RESET();
        int lane = C.lane; asm volatile("" : "+v"(lane));
        const int tid = wave * 64 + lane, r32 = lane & 31, h = lane >> 5;
        const int sc = unit & 63, bh = unit >> 6, b = bh >> 2, hh = bh & 3, tok0 = b * SEQ + sc * SC;
        const float mprev = MPREV[unit];
        __syncthreads();
        if (wave == 0) {
            float bb[4], aa[4]; gate_scalars(G, tok0, hh, lane, bb, aa);
            float cm[4]; cm[0] = aa[0]; cm[1] = fmaxf(cm[0], aa[1]); cm[2] = fmaxf(cm[1], aa[2]); cm[3] = fmaxf(cm[2], aa[3]);
            const float incl = scan_max(cm[3], lane); float excl = __shfl_up(incl, 1); if (lane == 0) excl = -INFINITY;
#pragma unroll
            for (int j = 0; j < 4; ++j) { sa[4 * lane + j] = aa[j]; sb[4 * lane + j] = bb[j]; sM[4 * lane + j] = fmaxf(mprev, fmaxf(excl, cm[j])); }
        }
        stage_tile_conv<false>(imgV, PR + ml_off(S_MQ, b, hh, sc * SC), P.conv_w + (size_t)layer * 4096 + hh * 128, P.conv_b + layer * 1024 + hh * 128, sc == 0, tid, nullptr);
        { const bf16* cg = CT + (size_t)unit * 16384; v4u cv[4];
#pragma unroll
          for (int i = 0; i < 4; ++i) { const int id = tid + 512 * i; cv[i] = *(const v4u*)(cg + (size_t)id * 8); }
#pragma unroll
          for (int i = 0; i < 4; ++i) { const int id = tid + 512 * i; *(LAS v4u*)(imgK + img_off(id >> 4, id & 15)) = cv[i]; }
          if (tid < 16) { const float* np = NL + (size_t)unit * 128 + 8 * tid; const f32x4 n0 = *(const f32x4*)np, n1 = *(const f32x4*)(np + 4);
              *(LAS bf16x8*)(imgK + img_off(128, tid)) = pack8(n0.x, n0.y, n0.z, n0.w, n1.x, n1.y, n1.z, n1.w); } }
        __syncthreads();
        TS_MARK(4);
        const int q0 = 32 * wave, tokq = tok0 + q0 + r32;
        bf16x8 qf[8];
#pragma unroll
        for (int ks = 0; ks < 8; ++ks) qf[ks] = *(const LAS bf16x8*)(imgV + img_off(q0 + r32, 2 * ks + h));
        f32x16 o0 = {}, o1 = {}, o2 = {}, o3 = {}, o4 = {};
        v4u vx[8];
        stage_tile_load(vx, PR + ml_off(S_MV, b, hh, sc * SC), 128, tid);
#pragma unroll
        for (int ks = 0; ks < 8; ++ks) {
            o0 = MFMA32(*(const LAS bf16x8*)(imgK + img_off(r32, 2 * ks + h)), qf[ks], o0);
            o1 = MFMA32(*(const LAS bf16x8*)(imgK + img_off(32 + r32, 2 * ks + h)), qf[ks], o1);
            o2 = MFMA32(*(const LAS bf16x8*)(imgK + img_off(64 + r32, 2 * ks + h)), qf[ks], o2);
            o3 = MFMA32(*(const LAS bf16x8*)(imgK + img_off(96 + r32, 2 * ks + h)), qf[ks], o3);
            const bf16x8 nrow = *(const LAS bf16x8*)(imgK + img_off(128, 2 * ks + h)); const bf16x8 zf = {};
            o4 = MFMA32(r32 == 0 ? nrow : zf, qf[ks], o4);
        }
        TS_MARK(5);
        __syncthreads();
        stage_tile_store(imgV, vx, tid);
        stage_tile_conv<false>(imgK, PR + ml_off(S_MK, b, hh, sc * SC), P.conv_w + (size_t)layer * 4096 + 512 + hh * 128, P.conv_b + layer * 1024 + 512 + hh * 128, sc == 0, tid, nullptr);
        __syncthreads();
        TS_MARK(6);
        const float Mq = sM[q0 + r32];
        float den;
        { const float si = ML_SCALE * __expf(mprev - Mq); o0 *= si; o1 *= si; o2 *= si; o3 *= si; den = __shfl(o4[0], r32) * si; }
        float dsum = 0.f;
        for (int kt = 0; kt <= wave; ++kt) {
            f32x16 s = {};
#pragma unroll
            for (int ks = 0; ks < 8; ++ks) s = MFMA32(*(const LAS bf16x8*)(imgK + img_off(32 * kt + r32, 2 * ks + h)), qf[ks], s);
            float p[16];
#pragma unroll
            for (int g = 0; g < 4; ++g) { const f32x4 a4 = *(const LAS f32x4*)(sa + 32 * kt + 8 * g + 4 * h);
#pragma unroll
                for (int j = 0; j < 4; ++j) { float v = s[4 * g + j] * (ML_SCALE * __expf(a4[j] - Mq)); if (kt == wave && (8 * g + 4 * h + j) > r32) v = 0.f; p[4 * g + j] = v; dsum += v; } }
            const bf16x8 pf0 = pack8(p[0], p[1], p[2], p[3], p[4], p[5], p[6], p[7]), pf1 = pack8(p[8], p[9], p[10], p[11], p[12], p[13], p[14], p[15]);
#pragma unroll
            for (int s2 = 0; s2 < 2; ++s2) {
                const int rlo = 32 * kt + 16 * s2 + 4 * h, rhi = rlo + 8; const bf16x8 pf = s2 ? pf1 : pf0;
                o0 = MFMA32(tr_frag(imgV, lane, 0, rlo, rhi), pf, o0);
                o1 = MFMA32(tr_frag(imgV, lane, 1, rlo, rhi), pf, o1);
                o2 = MFMA32(tr_frag(imgV, lane, 2, rlo, rhi), pf, o2);
                o3 = MFMA32(tr_frag(imgV, lane, 3, rlo, rhi), pf, o3);
            }
        }
        TS_MARK(7);
        den += dsum + __shfl_xor(dsum, 32);
        const float inv = 1.0f / fmaxf(fabsf(den), __expf(-(sb[q0 + r32] + Mq)));
        const int chk = lane & 7;
        v4u og[4][2], zg[4][2];
#pragma unroll
        for (int i = 0; i < 4; ++i) { const int trow = sc * SC + q0 + (lane >> 3) + 8 * i; const bf16* op = PR + ml_off(S_MO, b, hh, trow) + 16 * chk; const bf16* zp = PR + ml_off(S_MZ, b, hh, trow) + 16 * chk;
            og[i][0] = *(const v4u*)op; og[i][1] = *(const v4u*)(op + 8); zg[i][0] = *(const v4u*)zp; zg[i][1] = *(const v4u*)(zp + 8); }
        __syncthreads();
        LAS unsigned char* st = C.lds + wave * 16896;
#define ML_ST(OV, EB) _Pragma("unroll") for (int g = 0; g < 4; ++g) *(LAS f32x4*)(st + r32 * 528 + (32 * (EB) + 8 * g + 4 * h) * 4) = (f32x4){OV[4 * g] * inv, OV[4 * g + 1] * inv, OV[4 * g + 2] * inv, OV[4 * g + 3] * inv};
        ML_ST(o0, 0) ML_ST(o1, 1) ML_ST(o2, 2) ML_ST(o3, 3)
#undef ML_ST
        f32x4 mw4[4];
#pragma unroll
        for (int k = 0; k < 4; ++k) mw4[k] = *(const f32x4*)(P.mnorm_w + layer * 512 + hh * 128 + 16 * chk + 4 * k);
#pragma unroll
        for (int i = 0; i < 4; ++i) {
            const int row = (lane >> 3) + 8 * i;
            const v4u og0 = og[i][0], og1 = og[i][1], zg0 = zg[i][0], zg1 = zg[i][1];
            float hv[16];
#pragma unroll
            for (int k = 0; k < 4; ++k) { const f32x4 x = *(const LAS f32x4*)(st + row * 528 + chk * 64 + 16 * k); hv[4 * k] = x.x; hv[4 * k + 1] = x.y; hv[4 * k + 2] = x.z; hv[4 * k + 3] = x.w; }
            const float gq[16] = {bflo(og0.x), bfhi(og0.x), bflo(og0.y), bfhi(og0.y), bflo(og0.z), bfhi(og0.z), bflo(og0.w), bfhi(og0.w), bflo(og1.x), bfhi(og1.x), bflo(og1.y), bfhi(og1.y), bflo(og1.z), bfhi(og1.z), bflo(og1.w), bfhi(og1.w)};
            const float zq[16] = {bflo(zg0.x), bfhi(zg0.x), bflo(zg0.y), bfhi(zg0.y), bflo(zg0.z), bfhi(zg0.z), bflo(zg0.w), bfhi(zg0.w), bflo(zg1.x), bfhi(zg1.x), bflo(zg1.y), bfhi(zg1.y), bflo(zg1.z), bfhi(zg1.z), bflo(zg1.w), bfhi(zg1.w)};
            float ss = 0.f;
#pragma unroll
            for (int k = 0; k < 16; ++k) { hv[k] *= gq[k]; ss += hv[k] * hv[k]; }
            ss += __shfl_xor(ss, 1); ss += __shfl_xor(ss, 2); ss += __shfl_xor(ss, 4);
            const float rn = rsqrtf(ss * (1.f / 128.f) + EPS);
            float y[16];
#pragma unroll
            for (int k = 0; k < 16; ++k) y[k] = hv[k] * rn * mw4[k >> 2][k & 3] * zq[k];
            bf16* yp = Y + (size_t)(tok0 + q0 + row) * 1024 + hh * 128 + 16 * chk;
            v4u w0, w1; w0.x = cvtpk(y[0], y[1]); w0.y = cvtpk(y[2], y[3]); w0.z = cvtpk(y[4], y[5]); w0.w = cvtpk(y[6], y[7]); w1.x = cvtpk(y[8], y[9]); w1.y = cvtpk(y[10], y[11]); w1.z = cvtpk(y[12], y[13]); w1.w = cvtpk(y[14], y[15]);
            *(v4u*)yp = w0; *(v4u*)(yp + 8) = w1;
        }
        (void)tokq;
        if (TS_PROBE >= 70) asm volatile("s_waitcnt vmcnt(0)" ::: "memory"); TS_MARK(8);
    }
}
constexpr size_t OFF_SELP = 496 * MiB;
constexpr size_t OFF_LPART = 497 * MiB;
constexpr int LDS_MK = 0, LDS_MV = 32768, LDS_MQ = 65536, LDS_MCNT = 65536 + 16384;
constexpr float LOG2E = 1.4426950408889634f;

DI int mk_off(int row, int ch) { return 128 * row + 16 * (ch ^ ((row >> 1) & 7)); }
DI int mv_off(int row, int half) { return 128 * row + 64 * (half ^ ((row >> 1) & 1)); }
DI void moba_stage_load(v4u (&kv)[4], v4u (&vv)[4], const bf16* kg, const bf16* vg, int tid) {
#pragma unroll
    for (int i = 0; i < 4; ++i) { const int id = tid + 512 * i, row = id >> 3, ch = id & 7; kv[i] = *(const v4u*)(kg + (size_t)row * 64 + ch * 8); vv[i] = *(const v4u*)(vg + (size_t)row * 64 + ch * 8); }
}
DI void moba_stage_store(LAS unsigned char* lds, const v4u (&kv)[4], const v4u (&vv)[4], int tid) {
#pragma unroll
    for (int i = 0; i < 4; ++i) { const int id = tid + 512 * i, row = id >> 3, ch = id & 7;
        *(LAS v4u*)(lds + LDS_MK + mk_off(row, ch)) = kv[i]; *(LAS v4u*)(lds + LDS_MV + mv_off(row, ch >> 2) + 16 * (ch & 3)) = vv[i]; }
}
DI void moba_stage(LAS unsigned char* lds, const bf16* kg, const bf16* vg, int tid) {
    v4u kv[4], vv[4];
#pragma unroll
    for (int i = 0; i < 4; ++i) { const int id = tid + 512 * i, row = id >> 3, ch = id & 7; kv[i] = *(const v4u*)(kg + (size_t)row * 64 + ch * 8); vv[i] = *(const v4u*)(vg + (size_t)row * 64 + ch * 8); }
#pragma unroll
    for (int i = 0; i < 4; ++i) { const int id = tid + 512 * i, row = id >> 3, ch = id & 7;
        *(LAS v4u*)(lds + LDS_MK + mk_off(row, ch)) = kv[i]; *(LAS v4u*)(lds + LDS_MV + mv_off(row, ch >> 2) + 16 * (ch & 3)) = vv[i]; }
}
template <bool MASK> DI void moba_kb(const LAS unsigned char* lds, int kb, const bf16x8 (&qf)[4], const float (&kbias)[16], float base, int r32, int h, int blk, int q4, int p4, f32x16& o0, f32x16& o1, float& l) {
    constexpr float C2 = 0.125f * LOG2E;
    f32x16 s = {};
#pragma unroll
    for (int ks = 0; ks < 4; ++ks) s = MFMA32(*(const LAS bf16x8*)(lds + LDS_MK + mk_off(32 * kb + r32, 2 * ks + h)), qf[ks], s);
    float p[16];
#pragma unroll
    for (int i = 0; i < 16; ++i) { float v = __builtin_amdgcn_exp2f(fmaf(s[i], C2, kbias[i] + base)); if (MASK && crow(i, h) > r32) v = 0.f; p[i] = v; l += v; }
    const bf16x8 pf0 = pack8(p[0], p[1], p[2], p[3], p[4], p[5], p[6], p[7]), pf1 = pack8(p[8], p[9], p[10], p[11], p[12], p[13], p[14], p[15]);
#pragma unroll
    for (int s2 = 0; s2 < 2; ++s2) {
        const int rlo = 32 * kb + 16 * s2 + 4 * h + q4, rhi = rlo + 8; const bf16x8 pf = s2 ? pf1 : pf0;
#pragma unroll
        for (int c = 0; c < 2; ++c) {
            const s16x4 lo = tr_read(lds + LDS_MV + mv_off(rlo, c) + 32 * blk + 8 * p4), hi = tr_read(lds + LDS_MV + mv_off(rhi, c) + 32 * blk + 8 * p4);
            const bf16x8 A = __builtin_shufflevector(lo, hi, 0, 1, 2, 3, 4, 5, 6, 7);
            if (c == 0) o0 = MFMA32(A, pf, o0); else o1 = MFMA32(A, pf, o1);
        }
    }
}
template <bool DIAG> DI void moba_tile(const LAS unsigned char* lds, int lane, const bf16x8 (&qf)[4], int nkb, float slope2, float base0, f32x16& o0, f32x16& o1, float& l) {
    const int r32 = lane & 31, h = lane >> 5, blk = (lane >> 4) & 1, q4 = (lane & 15) >> 2, p4 = lane & 3;
    float kbias[16];
#pragma unroll
    for (int i = 0; i < 16; ++i) kbias[i] = slope2 * (float)crow(i, h);
    const int nfull = DIAG ? nkb - 1 : nkb;
    int kb = 0;
    float l2 = 0.f;
    for (; kb + 1 < nfull; kb += 2) {
        moba_kb<false>(lds, kb, qf, kbias, base0 + slope2 * (float)(32 * kb), r32, h, blk, q4, p4, o0, o1, l);
        moba_kb<false>(lds, kb + 1, qf, kbias, base0 + slope2 * (float)(32 * kb + 32), r32, h, blk, q4, p4, o0, o1, l2);
    }
    if (kb < nfull) { moba_kb<false>(lds, kb, qf, kbias, base0 + slope2 * (float)(32 * kb), r32, h, blk, q4, p4, o0, o1, l); ++kb; }
    if (DIAG) moba_kb<true>(lds, kb, qf, kbias, base0 + slope2 * (float)(32 * kb), r32, h, blk, q4, p4, o0, o1, l2);
    l += l2;
}
DI int moba_live_dist(const Params& P, int layer, int hd, int lane) {
    const float mq = wave_max(fabsf(P.qn_w[layer * 64 + lane])), mk = wave_max(fabsf(P.kn_w[layer * 64 + lane]));
    const float b2 = 8.0f * mq * mk * LOG2E * 1.01f, slope2 = exp2f(-(float)(hd + 1)) * LOG2E;
    const float d = (150.0f + b2) / slope2;
    return d > 1.0e6f ? 1000000 : (int)d + 1;
}

#define TOP3_INS(V, N) do { const float v_ = (V); const int n_ = (N); \
    if (v_ > v0 || (v_ == v0 && n_ < i0)) { v2 = v1; i2 = i1; v1 = v0; i1 = i0; v0 = v_; i0 = n_; } \
    else if (v_ > v1 || (v_ == v1 && n_ < i1)) { v2 = v1; i2 = i1; v1 = v_; i1 = n_; } \
    else if (v_ > v2 || (v_ == v2 && n_ < i2)) { v2 = v_; i2 = n_; } } while (0)
DI void ph_select_mfma(const Params& P, const Ctx& C) {
    const bf16* PR = (const bf16*)(P.ws + OFF_PROJ); const float* KM = (const float*)(P.ws + OFF_KMEAN); unsigned* SELP = (unsigned*)(P.ws + OFF_SELP);
    const int wave = C.wave, bid = C.gw >> 3, nb = C.ngw >> 3;
    const int bh = bid & 15, b = bh >> 3, hd = bh & 7, m = bid >> 4, nm = (nb + 15 - bh) >> 4;
    __syncthreads();
    { const int tid = wave * 64 + C.lane, row = tid >> 3, ch = tid & 7;
      const float* kp = KM + ((size_t)bh * 64 + row) * 128 + 8 * ch;
      const f32x4 a = (*(const f32x4*)kp + *(const f32x4*)(kp + 64)) * (1.f / 256.f), c = (*(const f32x4*)(kp + 4) + *(const f32x4*)(kp + 68)) * (1.f / 256.f);
      v4u hi; hi.x = cvtpk(a.x, a.y); hi.y = cvtpk(a.z, a.w); hi.z = cvtpk(c.x, c.y); hi.w = cvtpk(c.z, c.w);
      v4u lo; lo.x = cvtpk(a.x - bflo(hi.x), a.y - bfhi(hi.x)); lo.y = cvtpk(a.z - bflo(hi.y), a.w - bfhi(hi.y)); lo.z = cvtpk(c.x - bflo(hi.z), c.y - bfhi(hi.z)); lo.w = cvtpk(c.z - bflo(hi.w), c.w - bfhi(hi.w));
      *(LAS v4u*)(C.lds + mk_off(row, ch)) = hi; *(LAS v4u*)(C.lds + 8192 + mk_off(row, ch)) = lo; }
    __syncthreads();
    for (int qt = m + nm * wave; qt < 512; qt += nm * 8) {
        int lane = C.lane; asm volatile("" : "+v"(lane));
        const int r32 = lane & 31, h = lane >> 5;
        const int t0 = 32 * qt, j = t0 >> 8;
        unsigned* out = SELP + (size_t)bh * SEQ + t0 + r32;
        if (j == 0) { if (h == 0) *out = 0x00FFFFFFu; continue; }
        bf16x8 qf[4];
#pragma unroll
        for (int ks = 0; ks < 4; ++ks) qf[ks] = *(const bf16x8*)(PR + at_off(S_AQ, b, hd, t0 + r32) + 16 * ks + 8 * h);
        float v0 = -INFINITY, v1 = -INFINITY, v2 = -INFINITY; int i0 = 255, i1 = 255, i2 = 255;
        const int nbk = j > 32 ? 2 : 1;
        for (int nbi = 0; nbi < nbk; ++nbi) {
            f32x16 acc = {};
#pragma unroll
            for (int ks = 0; ks < 4; ++ks) {
                const bf16x8 hi = *(const LAS bf16x8*)(C.lds + mk_off(32 * nbi + r32, 2 * ks + h)), lo = *(const LAS bf16x8*)(C.lds + 8192 + mk_off(32 * nbi + r32, 2 * ks + h));
                acc = MFMA32(hi, qf[ks], acc); acc = MFMA32(lo, qf[ks], acc);
            }
#pragma unroll
            for (int i = 0; i < 16; ++i) { const int n = 32 * nbi + crow(i, h); if (n < j) TOP3_INS(acc[i], n); }
        }
        const float w0 = __shfl_xor(v0, 32), w1 = __shfl_xor(v1, 32), w2 = __shfl_xor(v2, 32); const int k0 = __shfl_xor(i0, 32), k1 = __shfl_xor(i1, 32), k2 = __shfl_xor(i2, 32);
        if (k0 != 255) TOP3_INS(w0, k0);
        if (k1 != 255) TOP3_INS(w1, k1);
        if (k2 != 255) TOP3_INS(w2, k2);
        if (h == 0) *out = (unsigned)i0 | ((unsigned)i1 << 8) | ((unsigned)i2 << 16);
    }
}

constexpr int CW_WQ = 8192;
constexpr int LDS_MQ2 = 65536, LDS_MSCR = 98304, LDS_MCTL = 136192;
DI void ph_moba_sel_mfma(const Params& P, const Ctx& C, int layer) {
    const int wave = C.wave;
    const bf16* PR = (const bf16*)(P.ws + OFF_PROJ); bf16* Y = (bf16*)(P.ws + OFF_Y); bf16* XNB = (bf16*)P.out;     const unsigned* SELP = (const unsigned*)(P.ws + OFF_SELP); float* LP = (float*)(P.ws + OFF_LPART);
    unsigned* head = (unsigned*)(P.ws + OFF_CTL) + CW_WQ + 64 * layer;
    LAS unsigned short* queue = (LAS unsigned short*)(C.lds + LDS_MQ2); LAS unsigned* ctl = (LAS unsigned*)(C.lds + LDS_MCTL);
    for (;;) {
        int lane = C.lane; asm volatile("" : "+v"(lane));
        const int tid = wave * 64 + lane, r32 = lane & 31, h = lane >> 5;
        __syncthreads();
        if (tid == 0) { ctl[1] = __hip_atomic_fetch_add(head, 1u, __ATOMIC_RELAXED, __HIP_MEMORY_SCOPE_AGENT); ctl[0] = 0u; }
        __syncthreads();
        const int it = (int)ctl[1];
        if (it >= 16 * 63) break;
        const int bh = it & 15, b = bh >> 3, hd = bh & 7, n = it >> 4;
        const int lim = moba_live_dist(P, layer, hd, lane);
        int t_end = 256 * n + 256 + lim; t_end = t_end > SEQ ? SEQ : ((t_end + 63) & ~63);
        const unsigned* sp = SELP + (size_t)bh * SEQ;
        for (int t = 256 * (n + 1) + 64 * wave + lane; t < t_end; t += 512) {
            const unsigned sel = sp[t];
            int slot = ((sel & 0xFFu) == (unsigned)n) ? 0 : (((sel >> 8) & 0xFFu) == (unsigned)n) ? 1 : (((sel >> 16) & 0xFFu) == (unsigned)n) ? 2 : -1;
            if (t - 256 * n - 255 > lim) slot = -1;
            const unsigned long long mask = __ballot(slot >= 0);
            if (mask) {
                unsigned base = 0; if (lane == 0) base = __hip_atomic_fetch_add(ctl, (unsigned)__popcll(mask), __ATOMIC_RELAXED, __HIP_MEMORY_SCOPE_WORKGROUP);
                base = __shfl(base, 0);
                if (slot >= 0) queue[base + __popcll(mask & ((1ull << lane) - 1ull))] = (unsigned short)((unsigned)t | ((unsigned)slot << 14));
            }
        }
        __syncthreads();
        if (ctl[0] == 0u) continue;
        moba_stage(C.lds, PR + at_off(S_AK, b, hd, n * 256), PR + at_off(S_AV, b, hd, n * 256), tid);
        __syncthreads();
        const int total = (int)ctl[0], ntiles = (total + 31) >> 5;
        const float slope2 = exp2f(-(float)(hd + 1)) * LOG2E;
        int tile = wave; unsigned e = 0; bf16x8 qf[4] = {};
        if (tile < ntiles) { const int idx = tile * 32 + r32; e = queue[idx < total ? idx : 0]; const int tq = e & 0x3FFF;
#pragma unroll
            for (int ks = 0; ks < 4; ++ks) qf[ks] = *(const bf16x8*)(PR + at_off(S_AQ, b, hd, tq) + 16 * ks + 8 * h); }
        while (tile < ntiles) {
            const int nxt = tile + 8; unsigned en = 0; bf16x8 qn[4] = {};
            if (nxt < ntiles) { const int idx = nxt * 32 + r32; en = queue[idx < total ? idx : 0]; const int tqn = en & 0x3FFF;
#pragma unroll
                for (int ks = 0; ks < 4; ++ks) qn[ks] = *(const bf16x8*)(PR + at_off(S_AQ, b, hd, tqn) + 16 * ks + 8 * h); }
            const bool valid = tile * 32 + r32 < total; const int t = e & 0x3FFF, slot = e >> 14; const size_t tok = (size_t)b * SEQ + t;
            f32x16 o0 = {}, o1 = {}; float l = 0.f;
            moba_tile<false>(C.lds, lane, qf, 8, slope2, slope2 * (float)(n * 256 - t), o0, o1, l);
            l += __shfl_xor(l, 32);
            (void)valid; (void)slot; (void)tok;
            { LAS unsigned char* st = C.lds + LDS_MSCR + wave * 4608;
#pragma unroll
              for (int g = 0; g < 4; ++g) { u32x2 w; w.x = cvtpk(o0[4 * g], o0[4 * g + 1]); w.y = cvtpk(o0[4 * g + 2], o0[4 * g + 3]); *(LAS u32x2*)(st + r32 * 144 + (8 * g + 4 * h) * 2) = w;
                  w.x = cvtpk(o1[4 * g], o1[4 * g + 1]); w.y = cvtpk(o1[4 * g + 2], o1[4 * g + 3]); *(LAS u32x2*)(st + r32 * 144 + (32 + 8 * g + 4 * h) * 2) = w; }
#pragma unroll
              for (int i = 0; i < 4; ++i) { const int row = (lane >> 3) + 8 * i, chk = lane & 7, idx = tile * 32 + row;
                  const v4u w = *(const LAS v4u*)(st + row * 144 + chk * 16);
                  const float lr = __shfl(l, row);
                  if (idx < total) { const unsigned er = queue[idx]; const int tr = er & 0x3FFF, sr = er >> 14; const size_t tokr = (size_t)b * SEQ + tr;
                      bf16* dst = (sr < 2) ? XNB + tokr * 1024 + (sr * 8 + hd) * 64 : Y + tokr * 1024 + 512 + hd * 64;
                      *(v4u*)(dst + chk * 8) = w;
                      if (chk == 0) LP[(tokr * 8 + hd) * 4 + sr] = lr; } } }
            tile = nxt; e = en;
#pragma unroll
            for (int ks = 0; ks < 4; ++ks) qf[ks] = qn[ks];
        }
    }
}

DI void ph_moba_own_mfma(const Params& P, const Ctx& C, int layer) {
    const int wave = C.wave, bid = C.gw >> 3, nb = C.ngw >> 3;
    const bf16* PR = (const bf16*)(P.ws + OFF_PROJ); bf16* Y = (bf16*)(P.ws + OFF_Y); const float* LP = (const float*)(P.ws + OFF_LPART);
    const int i0 = bid, i1 = 16 * NBLK, istep = nb;
    TS_DECL;
    v4u pk[4], pv[4];
    if (i0 < i1) { const int bh = ((i0 & 15) + 5 * (i0 >> 8)) & 15; moba_stage_load(pk, pv, PR + at_off(S_AK, bh >> 3, bh & 7, (i0 >> 4) * 256), PR + at_off(S_AV, bh >> 3, bh & 7, (i0 >> 4) * 256), wave * 64 + C.lane); }
    for (int it = i0; it < i1; it += istep) {
        int lane = C.lane; asm volatile("" : "+v"(lane));
        const int tid = wave * 64 + lane, r32 = lane & 31, h = lane >> 5;
        const int bh = ((it & 15) + 5 * (it >> 8)) & 15, b = bh >> 3, hd = bh & 7, j = it >> 4;
        TS_RESET();
        __syncthreads();
        moba_stage_store(C.lds, pk, pv, tid);
        __syncthreads();
        TS_MARK(0);
        if (it + istep < i1) { const int itn = it + istep, bhn = ((itn & 15) + 5 * (itn >> 8)) & 15; moba_stage_load(pk, pv, PR + at_off(S_AK, bhn >> 3, bhn & 7, (itn >> 4) * 256), PR + at_off(S_AV, bhn >> 3, bhn & 7, (itn >> 4) * 256), tid); }
        const int tl = 32 * wave + r32;
        bf16x8 qf[4];
#pragma unroll
        for (int ks = 0; ks < 4; ++ks) qf[ks] = *(const bf16x8*)(PR + at_off(S_AQ, b, hd, j * 256 + tl) + 16 * ks + 8 * h);
        const float slope2 = exp2f(-(float)(hd + 1)) * LOG2E;
        f32x16 o0 = {}, o1 = {}; float l = 0.f;
        moba_tile<true>(C.lds, lane, qf, wave + 1, slope2, -slope2 * (float)tl, o0, o1, l);
        l += __shfl_xor(l, 32);
        TS_MARK(1);
        const int lim = moba_live_dist(P, layer, hd, lane);
        LAS unsigned char* st = C.lds + 65536 + wave * 9216;
#pragma unroll
        for (int g = 0; g < 4; ++g) { *(LAS f32x4*)(st + r32 * 272 + (8 * g + 4 * h) * 4) = (f32x4){o0[4 * g], o0[4 * g + 1], o0[4 * g + 2], o0[4 * g + 3]};
            *(LAS f32x4*)(st + r32 * 272 + (32 + 8 * g + 4 * h) * 4) = (f32x4){o1[4 * g], o1[4 * g + 1], o1[4 * g + 2], o1[4 * g + 3]}; }
        const unsigned* selp = (const unsigned*)(P.ws + OFF_SELP) + (size_t)bh * SEQ + j * 256 + 32 * wave;
#pragma unroll
        for (int i = 0; i < 4; ++i) {
            const int row = (lane >> 3) + 8 * i, chk = lane & 7, tpos = j * 256 + 32 * wave + row; const size_t tokr = (size_t)b * SEQ + tpos;
            const f32x4 a = *(const LAS f32x4*)(st + row * 272 + chk * 32), c = *(const LAS f32x4*)(st + row * 272 + chk * 32 + 16);
            float v[8] = {a.x, a.y, a.z, a.w, c.x, c.y, c.z, c.w};
            float lr = __shfl(l, row);
            const unsigned sel = selp[row]; const int n0 = sel & 0xFF, n1 = (sel >> 8) & 0xFF, n2 = (sel >> 16) & 0xFF;
            const bool live0 = n0 != 255 && tpos - 256 * n0 - 255 <= lim, live1 = n1 != 255 && tpos - 256 * n1 - 255 <= lim, live2 = n2 != 255 && tpos - 256 * n2 - 255 <= lim;
            const f32x4 lp = *(const f32x4*)(LP + (tokr * 8 + hd) * 4);
            const bf16* p0 = (const bf16*)P.out + tokr * 1024 + hd * 64 + chk * 8; bf16* yp = Y + tokr * 1024 + 512 + hd * 64 + chk * 8;
#define ADD8(W) do { v[0] += bflo((W).x); v[1] += bfhi((W).x); v[2] += bflo((W).y); v[3] += bfhi((W).y); v[4] += bflo((W).z); v[5] += bfhi((W).z); v[6] += bflo((W).w); v[7] += bfhi((W).w); } while (0)
            const bf16* zp = PR + at_off(S_AZ, b, hd, tpos) + chk * 8;
            const v4u w0 = *(const v4u*)(live0 ? p0 : zp), w1 = *(const v4u*)(live1 ? p0 + 512 : zp), w2 = *(const v4u*)(live2 ? (const bf16*)yp : zp);
            const v4u z = *(const v4u*)zp; const v4u zero4 = {0u, 0u, 0u, 0u};
            { const v4u w = live0 ? w0 : zero4; ADD8(w); lr += live0 ? lp.x : 0.f; }
            { const v4u w = live1 ? w1 : zero4; ADD8(w); lr += live1 ? lp.y : 0.f; }
            { const v4u w = live2 ? w2 : zero4; ADD8(w); lr += live2 ? lp.z : 0.f; }
#undef ADD8
            const float inv = 1.0f / lr;
            v4u y; y.x = cvtpk(v[0] * inv * bflo(z.x), v[1] * inv * bfhi(z.x)); y.y = cvtpk(v[2] * inv * bflo(z.y), v[3] * inv * bfhi(z.y));
            y.z = cvtpk(v[4] * inv * bflo(z.z), v[5] * inv * bfhi(z.z)); y.w = cvtpk(v[6] * inv * bflo(z.w), v[7] * inv * bfhi(z.w));
            *(v4u*)yp = y;
        }
        if (TS_PROBE >= 70) asm volatile("s_waitcnt vmcnt(0)" ::: "memory"); TS_MARK(2);
    }
}
typedef const __attribute__((address_space(4))) Params* KargPtr;
constexpr int CW_TS = 16384;

DI int mk_lane() { return (int)__builtin_amdgcn_mbcnt_hi(~0u, __builtin_amdgcn_mbcnt_lo(~0u, 0u)); }
template <int LAYER, int PH> DI void run_phase(LAS unsigned char* lds0, int wave_s) {
    KargPtr pk = (KargPtr)__builtin_amdgcn_kernarg_segment_ptr(); asm volatile("" : "+s"(pk));
    Params P; P.x = pk->x; P.norm_w = pk->norm_w; P.w_in = pk->w_in; P.b_i = pk->b_i; P.b_f = pk->b_f; P.conv_w = pk->conv_w; P.conv_b = pk->conv_b;
    P.mnorm_w = pk->mnorm_w; P.qn_w = pk->qn_w; P.kn_w = pk->kn_w; P.w_out = pk->w_out; P.out = pk->out; P.ws = pk->ws; P.ph_lo = 0; P.ph_hi = 0;
    int tid_ = wave_s * 64 + mk_lane(); asm volatile("" : "+v"(tid_));
    Ctx C; C.lds = lds0; C.tid = tid_; C.lane = tid_ & 63; C.wave = wave_s;
    int bid_ = blockIdx.x, gdim_ = gridDim.x; asm volatile("" : "+s"(bid_), "+s"(gdim_));
    C.gw = bid_ * 8 + C.wave; C.ngw = gdim_ * 8;
    constexpr int layer = LAYER;
#ifndef DUP_MASK
#define DUP_MASK 0
#endif
#define DUPN(bit) (((DUP_MASK) >> (bit)) & 1 ? 2 : 1)
    if constexpr (PH == -1) { for (int rep = 0; rep < DUPN(15); ++rep) { ph_prologue(P, C); __syncthreads(); } }
    else if constexpr (PH == 0) {
        pg8::Gemm g{(const pg8::bf16_t*)(P.ws + OFF_XN), (const pg8::bf16_t*)(P.ws + OFF_WIN) + (size_t)layer * PW * DM, NTOK, PW, DM};
        pg8::StaticOrder S; S.init(NTOK, PW, gdim_, bid_);
        const unsigned long long acts = (1ull << 12) | (1ull << 14) | (2ull << 16) | (2ull << 18) | (3ull << 20) | (3ull << 22) | (3ull << 24) | (3ull << 26) | (2ull << 32) | (2ull << 34);
        pg8::EpiProj E{(pg8::bf16_t*)(P.ws + OFF_PROJ), 14, acts, P.qn_w + layer * 64, P.kn_w + layer * 64, (float*)(P.ws + OFF_KMEAN), (const float*)(P.ws + OFF_SSQ)};
        for (int rep = 0; rep < DUPN(1); ++rep) pg8::gemm_phase<pg8::EpiProj, pg8::StaticOrder, true, true>(C.lds, g, S, E, C.tid);
        ph_gates_mfma(P, C, layer);
    }
    else if constexpr (PH == 1) { ph_cloc_mfma(P, C, layer); ph_select_mfma(P, C); }
    else if constexpr (PH == 2) { ph_scan_bf16(P, C); ph_moba_sel_mfma(P, C, layer); }
    else if constexpr (PH == 3) {
        const int par = bid_ & 1;
#pragma unroll 1
        for (int s_ = 0; s_ < 2; ++s_) { if ((s_ ^ par) == 0) ph_mlstm_out_mfma(P, C, layer); else ph_moba_own_mfma(P, C, layer); }
    }
    else {
        pg8::Gemm g{(const pg8::bf16_t*)(P.ws + OFF_Y), (const pg8::bf16_t*)(P.ws + OFF_WOUT) + (size_t)layer * DM * DM, NTOK, DM, DM};
        pg8::StaticOrder S; S.init(NTOK, DM, gdim_, bid_);
        pg8::EpiRes E{(pg8::bf16_t*)(P.ws + OFF_XN), P.out, (float*)(P.ws + OFF_SSQ), DM, layer == NLAYER - 1 ? 1 : 0, 1.0f};
        pg8::gemm_phase<pg8::EpiRes, pg8::StaticOrder, true, true>(C.lds, g, S, E, C.tid);
        if (DUPN(7) > 1) { __syncthreads(); pg8::EpiRes E2{(pg8::bf16_t*)(P.ws + OFF_XN), P.out, (float*)(P.ws + OFF_SSQ), DM, layer == NLAYER - 1 ? 1 : 0, 0.0f}; pg8::gemm_phase<pg8::EpiRes, pg8::StaticOrder, true, true>(C.lds, g, S, E2, C.tid); }
    }
}
DI void grid_bar(LAS unsigned char* lds0, int wave_s) {
    KargPtr pb = (KargPtr)__builtin_amdgcn_kernarg_segment_ptr(); asm volatile("" : "+s"(pb));
    XcdBarrier bar; bar.bar = (unsigned*)(pb->ws + OFF_CTL) + CW_BAR; bar.x = xb_xcc_id(); bar.st = (volatile LAS unsigned*)(lds0 + MISC_OFF) + 8;
    xcd_barrier(bar, wave_s == 0 && mk_lane() == 0);
}
DI void ts_stamp(int gp, int wave_s) {
    if (TS_PROBE >= 0 && blockIdx.x == 0 && wave_s == 0 && mk_lane() == 0) {
        KargPtr pb = (KargPtr)__builtin_amdgcn_kernarg_segment_ptr();
        ((unsigned long long*)((unsigned*)(pb->ws + OFF_CTL) + CW_TS))[gp] = __builtin_amdgcn_s_memrealtime();
    }
}
#define RUN(GP, LAYER, PH) do { if (lo <= (GP) && (GP) < hi) { ts_stamp(GP, wave_s); run_phase<LAYER, PH>(lds0, wave_s); if (TS_PROBE >= 80) { __syncthreads(); ts_stamp(64 + (GP), wave_s); } if ((GP) + 1 < hi || TS_PROBE >= 0) { grid_bar(lds0, wave_s); if (DUPN(8) > 1) grid_bar(lds0, wave_s); } } } while (0)
#define RUN_LAYER(L) RUN(1 + 5 * (L) + 0, L, 0); RUN(1 + 5 * (L) + 1, L, 1); RUN(1 + 5 * (L) + 2, L, 2); RUN(1 + 5 * (L) + 3, L, 3); RUN(1 + 5 * (L) + 4, L, 4)
__global__ void __launch_bounds__(512, 2) fwd_kernel(Params P_karg) {
    extern __shared__ __attribute__((aligned(16))) unsigned char lds_raw[];
    LAS unsigned char* const lds0 = (LAS unsigned char*)lds_raw;
    const int wave_s = __builtin_amdgcn_readfirstlane((int)threadIdx.x >> 6);
    if (wave_s == 0) ((LAS unsigned*)(lds0 + MISC_OFF))[mk_lane()] = 0u;
    __syncthreads();
    int lo, hi;
    { KargPtr pk = (KargPtr)__builtin_amdgcn_kernarg_segment_ptr(); lo = pk->ph_lo; hi = pk->ph_hi;
      if (hi - lo > 1) (void)xcd_barrier_post((unsigned*)(pk->ws + OFF_CTL) + CW_BAR, (volatile LAS unsigned*)(lds0 + MISC_OFF) + 8, wave_s == 0 && mk_lane() == 0); }
    RUN(0, 0, -1);
    RUN_LAYER(0); RUN_LAYER(1); RUN_LAYER(2); RUN_LAYER(3);
    if (TS_PROBE >= 0) {
        ts_stamp(NGP, wave_s);
        grid_bar(lds0, wave_s);
        KargPtr pk = (KargPtr)__builtin_amdgcn_kernarg_segment_ptr();
        const unsigned long long* ts = (const unsigned long long*)((const unsigned*)(pk->ws + OFF_CTL) + CW_TS);
        float t_us = 400.f;
        if (TS_PROBE >= 80 && TS_PROBE < 90) { unsigned long long sum = 0; for (int l = 0; l < NLAYER; ++l) sum += ts[1 + NPH * l + (TS_PROBE - 80) + 1] - ts[64 + 1 + NPH * l + (TS_PROBE - 80)]; t_us = (float)sum * 0.01f; }
        else if (TS_PROBE >= 70 && TS_PROBE < 90) { t_us = (float)(((const unsigned*)(pk->ws + OFF_CTL) + CW_TS + 256)[TS_PROBE - 70]) * 0.01f; }
        else if (TS_PROBE < 90) { unsigned long long sum = 0; if (TS_PROBE == 50) sum = ts[1] - ts[0];
            else for (int l = 0; l < NLAYER; ++l) sum += ts[1 + NPH * l + TS_PROBE + 1] - ts[1 + NPH * l + TS_PROBE]; t_us = (float)sum * 0.01f; }
        const float a = 0.05f * sqrtf(t_us * 0.01f * TS_SCALE);
        const int gt = blockIdx.x * 512 + wave_s * 64 + mk_lane();
        for (int i = gt; i < (1 << 20); i += gridDim.x * 512) pk->out[(size_t)i * 32] += a;
    }
}

#ifndef ONE_LAUNCH
#define ONE_LAUNCH 1
#endif
extern "C" void kernel_launch(void* const* d_in, const int* in_sizes, int n_in, void* d_out, int out_size, void* d_ws, size_t ws_size, hipStream_t stream) {
    static int grid = 0;
    if (grid == 0) {
        if (n_in != 11 || in_sizes[0] != NTOK * DM || out_size != NTOK * DM || ws_size < WS_END) { fprintf(stderr, "kernel_launch: unexpected shapes (n_in %d, in0 %d, out %d, ws %zu)\n", n_in, n_in > 0 ? in_sizes[0] : -1, out_size, ws_size); grid = -1; return; }
        int dev = 0, cus = 0, per_cu = 0;
        if (hipGetDevice(&dev) != hipSuccess || hipDeviceGetAttribute(&cus, hipDeviceAttributeMultiprocessorCount, dev) != hipSuccess) { grid = -1; return; }
        if (hipFuncSetAttribute((const void*)fwd_kernel, hipFuncAttributeMaxDynamicSharedMemorySize, LDS_BYTES) != hipSuccess) { fprintf(stderr, "kernel_launch: hipFuncSetAttribute failed\n"); grid = -1; return; }
        if (hipOccupancyMaxActiveBlocksPerMultiprocessor(&per_cu, (const void*)fwd_kernel, 512, LDS_BYTES) != hipSuccess || per_cu < 1) { fprintf(stderr, "kernel_launch: occupancy query says %d blocks per CU\n", per_cu); per_cu = 1; }
        (void)hipGetLastError();
        grid = cus;
    }
    if (grid < 0) return;
    (void)hipMemsetAsync((char*)d_ws + OFF_CTL, 0, CTL_BYTES, stream);
    Params p{};
    p.x = (const float*)d_in[0]; p.norm_w = (const float*)d_in[1]; p.w_in = (const float*)d_in[2]; p.b_i = (const float*)d_in[3]; p.b_f = (const float*)d_in[4];
    p.conv_w = (const float*)d_in[5]; p.conv_b = (const float*)d_in[6]; p.mnorm_w = (const float*)d_in[7]; p.qn_w = (const float*)d_in[8]; p.kn_w = (const float*)d_in[9]; p.w_out = (const float*)d_in[10];
    p.out = (float*)d_out; p.ws = (unsigned char*)d_ws;
#if ONE_LAUNCH
    p.ph_lo = 0; p.ph_hi = NGP;
    hipLaunchKernelGGL(fwd_kernel, dim3(grid), dim3(512), LDS_BYTES, stream, p);
#else
    for (int gp = 0; gp < NGP; ++gp) { p.ph_lo = gp; p.ph_hi = gp + 1; hipLaunchKernelGGL(fwd_kernel, dim3(grid), dim3(512), LDS_BYTES, stream, p); }
#endif
}
```

```cpp
#include <hip/hip_runtime.h>
#include <cstdio>
#include <cstdint>
#ifndef TS_SCALE
#define TS_SCALE 1.0f
#endif
#ifndef TS_PROBE
#define TS_PROBE -1
#endif
#define TS_DECL unsigned long long ts_last_ = 0; const bool ts_on_ = (TS_PROBE >= 70) && (C.gw >> 3) == 0 && C.wave == 7 && C.lane == 0; unsigned* ts_acc_ = (unsigned*)(P.ws) + 16384 + 256
#define TS_RESET() do { if (ts_on_) ts_last_ = __builtin_amdgcn_s_memrealtime(); } while (0)
#define TS_MARK(k) do { if (ts_on_) { const unsigned long long now_ = __builtin_amdgcn_s_memrealtime(); ts_acc_[k] += (unsigned)(now_ - ts_last_); ts_last_ = now_; } } while (0)
namespace pg8 {
#define PG8_LAS __attribute__((address_space(3)))
typedef unsigned short bf16_t;
typedef short bf16x8 __attribute__((ext_vector_type(8)));
typedef float f32x4 __attribute__((ext_vector_type(4)));
typedef unsigned u32x4 __attribute__((ext_vector_type(4)));
constexpr int BM = 256, BK = 64, HALF = 128, HTB = HALF * BK * 2  , STAGE_BYTES = 8 * HTB, NXCD = 8, WGM = 8;

__host__ __device__ __forceinline__ int lds_byte(int r, int c) { const int st = (r >> 4) * 2 + (c >> 5), rr = r & 15, cc = c & 31, ob = rr * 64 + cc * 2; return st * 1024 + (ob ^ (((ob >> 9) & 1) << 5)); }
__host__ __device__ __forceinline__ void stage_rc(int b, int& R, int& C) { const int st = b / 1024, sb = b % 1024, swz = sb ^ (((sb >> 9) & 1) << 5); R = (st >> 1) * 16 + swz / 64; C = (st & 1) * 32 + (swz % 64) / 2; }
__host__ __device__ __forceinline__ int perm32(int rho) { const int n = rho >> 4, i = rho & 15; return 8 * (i >> 2) + 4 * n + (i & 3); }

struct Unit { int pm, pn; };
struct Gemm { const bf16_t* A; const bf16_t* Bt; int M, N, K; };

struct StaticOrder {
    int nM, nN, nwg, G, c;
    __host__ __device__ void init(int M, int N, int G_, int c_) { nM = M / BM; nN = N / BM; nwg = nM * nN; G = G_; c = c_; }
    __host__ __device__ bool next(int i, Unit& u) const {
        const long L = (long)i * G + c; if (L >= nwg) return false;
        int wgid = (int)L; { const int q = nwg / NXCD, r = nwg % NXCD, xcd = wgid % NXCD, off = wgid / NXCD; wgid = (xcd < r ? xcd * (q + 1) : r * (q + 1) + (xcd - r) * q) + off; }
        const int nig = WGM * nN, gid = wgid / nig, fm = gid * WGM, gsz = (nM - fm) < WGM ? (nM - fm) : WGM;
        u.pm = fm + ((wgid % nig) % gsz); u.pn = (wgid % nig) / gsz; return true;
    }
    __device__ __forceinline__ void a_ready(const Unit&) const {}
    __device__ __forceinline__ void done(const Unit&) const {}
};

__device__ __forceinline__ unsigned cvt_pk_bf16(float lo, float hi) { unsigned r; asm volatile("v_cvt_pk_bf16_f32 %0, %1, %2" : "=v"(r) : "v"(lo), "v"(hi)); return r; }
typedef float f32x2 __attribute__((ext_vector_type(2)));
__device__ __forceinline__ float sigmoid_f(float v) { return __builtin_amdgcn_rcpf(1.0f + __builtin_amdgcn_exp2f(v * -1.4426950408889634f)); }
struct EpiProj {
    static constexpr bool PERM = true, AFTER_DRAIN = false;
    bf16_t* O; int seq_log2; unsigned long long acts; const float* qw; const float* kw;
    float* kmp;
    const float* ssq;
    __device__ __forceinline__ void operator()(const f32x4 (&acc)[2][2][4][2], const Unit& u, int wr, int wc, int fr, int fq) const {
        const int row0 = u.pm * BM + wr * 64 + fr, seq = 1 << seq_log2;
        const int act = (int)((acts >> (2 * u.pn)) & 3ull), sec = u.pn >> 1;
        bf16_t* secp = O + (size_t)sec * ((size_t)(2 * seq) * 512);
        float rs[2][4];
#pragma unroll
        for (int ai = 0; ai < 2; ++ai)
#pragma unroll
            for (int m = 0; m < 4; ++m) { const f32x4 s0 = *(const f32x4*)(ssq + (size_t)(row0 + ai * HALF + m * 16) * 16 + 4 * fq);
                float t = (s0[0] + s0[1]) + (s0[2] + s0[3]); t += __shfl_xor(t, 16); t += __shfl_xor(t, 32);
                rs[ai][m] = rsqrtf(t * (1.0f / 1024.0f) + 1e-6f); }
        if (act == 3) {
            const float* nw = (u.pn < 12 ? qw : kw) + 8 * fq;
            const f32x4 w00 = *(const f32x4*)(nw), w01 = *(const f32x4*)(nw + 4), w10 = *(const f32x4*)(nw + 32), w11 = *(const f32x4*)(nw + 36);
            const int head = (u.pn & 1) * 4 + wc;
            f32x4 ksum[4] = {{0.f, 0.f, 0.f, 0.f}, {0.f, 0.f, 0.f, 0.f}, {0.f, 0.f, 0.f, 0.f}, {0.f, 0.f, 0.f, 0.f}};
#pragma unroll
            for (int ai = 0; ai < 2; ++ai)
#pragma unroll
                for (int m = 0; m < 4; ++m) { const int r = row0 + ai * HALF + m * 16, b = r >> seq_log2, t = r & (seq - 1);
                    bf16_t* rowp = secp + ((size_t)(b * 8 + head) * seq + t) * 64 + 8 * fq;
                    const float rr = rs[ai][m]; f32x4 a = acc[ai][0][m][0] * rr, bb = acc[ai][0][m][1] * rr, c = acc[ai][1][m][0] * rr, d = acc[ai][1][m][1] * rr;
                    float ss = ((a[0] * a[0] + a[1] * a[1]) + (a[2] * a[2] + a[3] * a[3])) + ((bb[0] * bb[0] + bb[1] * bb[1]) + (bb[2] * bb[2] + bb[3] * bb[3]))
                             + ((c[0] * c[0] + c[1] * c[1]) + (c[2] * c[2] + c[3] * c[3])) + ((d[0] * d[0] + d[1] * d[1]) + (d[2] * d[2] + d[3] * d[3]));
                    ss += __shfl_xor(ss, 16); ss += __shfl_xor(ss, 32);
                    const float rn = rsqrtf(ss * (1.0f / 64.0f) + 1e-6f);
                    a = a * rn * w00; bb = bb * rn * w01; c = c * rn * w10; d = d * rn * w11;
                    u32x4 w; w.x = cvt_pk_bf16(a[0], a[1]); w.y = cvt_pk_bf16(a[2], a[3]); w.z = cvt_pk_bf16(bb[0], bb[1]); w.w = cvt_pk_bf16(bb[2], bb[3]);
                    *(u32x4*)(rowp) = w;
                    w.x = cvt_pk_bf16(c[0], c[1]); w.y = cvt_pk_bf16(c[2], c[3]); w.z = cvt_pk_bf16(d[0], d[1]); w.w = cvt_pk_bf16(d[2], d[3]);
                    *(u32x4*)(rowp + 32) = w;
                    ksum[0] += a; ksum[1] += bb; ksum[2] += c; ksum[3] += d; }
            if (u.pn >= 12) {
#pragma unroll
                for (int v = 0; v < 4; ++v)
#pragma unroll
                    for (int i = 0; i < 4; ++i) { float x = ksum[v][i]; x += __shfl_xor(x, 1); x += __shfl_xor(x, 2); x += __shfl_xor(x, 4); x += __shfl_xor(x, 8); ksum[v][i] = x; }
                int fql = fq; asm volatile("" : "+v"(fql));
                if (fr == 0) { float* kp = kmp + ((((size_t)(u.pm >> 6) * 8 + head) * 64 + (u.pm & 63)) * 2 + wr) * 64 + 8 * fql;
                    *(f32x4*)(kp) = ksum[0]; *(f32x4*)(kp + 4) = ksum[1]; *(f32x4*)(kp + 32) = ksum[2]; *(f32x4*)(kp + 36) = ksum[3]; }
            }
            return;
        }
        const bool wide = sec < 5;
#pragma unroll
        for (int ai = 0; ai < 2; ++ai)
#pragma unroll
            for (int m = 0; m < 4; ++m) { const int r = row0 + ai * HALF + m * 16, b = r >> seq_log2, t = r & (seq - 1);
#pragma unroll
                for (int bj = 0; bj < 2; ++bj) { f32x4 v0 = acc[ai][bj][m][0] * rs[ai][m], v1 = acc[ai][bj][m][1] * rs[ai][m];
                    if (act != 0) {
#pragma unroll
                        for (int i = 0; i < 4; ++i) { const float s0 = sigmoid_f(v0[i]), s1 = sigmoid_f(v1[i]); v0[i] = (act == 1) ? s0 : v0[i] * s0; v1[i] = (act == 1) ? s1 : v1[i] * s1; }
                    }
                    bf16_t* dst = wide ? secp + ((size_t)(b * 4 + (u.pn & 1) * 2 + bj) * seq + t) * 128 + 32 * wc + 8 * fq
                                       : secp + ((size_t)(b * 8 + (u.pn & 1) * 4 + 2 * bj + (wc >> 1)) * seq + t) * 64 + (wc & 1) * 32 + 8 * fq;
                    u32x4 w; w.x = cvt_pk_bf16(v0[0], v0[1]); w.y = cvt_pk_bf16(v0[2], v0[3]); w.z = cvt_pk_bf16(v1[0], v1[1]); w.w = cvt_pk_bf16(v1[2], v1[3]);
                    *(u32x4*)dst = w; } }
    }
};
struct EpiRes {
    static constexpr bool PERM = true, AFTER_DRAIN = false;
    bf16_t* xb; float* out; float* ssq; int ldc; int last; float scale;
    __device__ __forceinline__ void operator()(const f32x4 (&acc)[2][2][4][2], const Unit& u, int wr, int wc, int fr, int fq) const {
        const int col0 = u.pn * BM + wc * 32 + 8 * fq;
        u32x4 xres[2][4][2];
#pragma unroll
        for (int ai = 0; ai < 2; ++ai)
#pragma unroll
            for (int m = 0; m < 4; ++m)
#pragma unroll
                for (int bj = 0; bj < 2; ++bj) xres[ai][m][bj] = *(const u32x4*)(xb + (size_t)(u.pm * BM + ai * HALF + wr * 64 + m * 16 + fr) * ldc + col0 + bj * HALF);
#pragma unroll
        for (int ai = 0; ai < 2; ++ai)
#pragma unroll
            for (int m = 0; m < 4; ++m) { const int row = u.pm * BM + ai * HALF + wr * 64 + m * 16 + fr; const size_t off = (size_t)row * ldc + col0; float sq = 0.f;
#pragma unroll
                for (int bj = 0; bj < 2; ++bj) { const u32x4 xr = xres[ai][m][bj];
                    f32x4 v0 = acc[ai][bj][m][0] * scale, v1 = acc[ai][bj][m][1] * scale;
                    v0[0] += __uint_as_float(xr.x << 16); v0[1] += __uint_as_float(xr.x & 0xffff0000u); v0[2] += __uint_as_float(xr.y << 16); v0[3] += __uint_as_float(xr.y & 0xffff0000u);
                    v1[0] += __uint_as_float(xr.z << 16); v1[1] += __uint_as_float(xr.z & 0xffff0000u); v1[2] += __uint_as_float(xr.w << 16); v1[3] += __uint_as_float(xr.w & 0xffff0000u);
                    if (last) { *(f32x4*)(out + off + bj * HALF) = v0; *(f32x4*)(out + off + bj * HALF + 4) = v1; }
                    else { u32x4 w; w.x = cvt_pk_bf16(v0[0], v0[1]); w.y = cvt_pk_bf16(v0[2], v0[3]); w.z = cvt_pk_bf16(v1[0], v1[1]); w.w = cvt_pk_bf16(v1[2], v1[3]); *(u32x4*)(xb + off + bj * HALF) = w;
                        sq += ((v0[0] * v0[0] + v0[1] * v0[1]) + (v0[2] * v0[2] + v0[3] * v0[3])) + ((v1[0] * v1[0] + v1[1] * v1[1]) + (v1[2] * v1[2] + v1[3] * v1[3])); } }
                if (!last) { sq += __shfl_xor(sq, 16); sq += __shfl_xor(sq, 32); if (fq == 0) ssq[(size_t)row * 16 + u.pn * 4 + wc] = sq; } }
    }
};
template <class Epi, class Sched, bool ALIGN_EPI = false, bool SP2 = false>
__device__ __forceinline__ void gemm_phase(PG8_LAS unsigned char* lds, const Gemm g, const Sched& S, const Epi& E, int tid_in) {
    int tid_l = tid_in; asm volatile("" : "+v"(tid_l));
    const int tid = tid_l, wid = __builtin_amdgcn_readfirstlane(tid >> 6), lane = tid & 63, wr = wid >> 2, wc = wid & 3, fr = lane & 15, fq = lane >> 4;
    const int K = g.K, nt = K / BK;
    unsigned voffA[2], voffB[2];
#pragma unroll
    for (int i = 0; i < 2; ++i) { int R, C; stage_rc(tid * 16 + i * 8192, R, C); const int Rb = Epi::PERM ? ((R & ~31) + perm32(R & 31)) : R;
        voffA[i] = (unsigned)(R * K + C) * 2u; voffB[i] = (unsigned)(Rb * K + C) * 2u; }
    const size_t kstep = (size_t)(BK * 2);
    const size_t hstep = (size_t)HALF * K * 2;
    const size_t tstep = 2 * hstep;
    const unsigned ldsw = (unsigned)wid * 1024u;
    const int aoff = lds_byte(wr * 64 + fr, fq * 8), boff = lds_byte(wc * 32 + fr, fq * 8);
#define PG8_SA(b, h) (((b) * 2 + (h)) * HTB)
#define PG8_SB(b, h) ((4 + (b) * 2 + (h)) * HTB)
#define PG8_STAGE(bufoff, gbase, voff) do { _Pragma("unroll") for (int _i = 0; _i < 2; ++_i) \
        __builtin_amdgcn_global_load_lds((const unsigned*)((const char*)(gbase) + (voff)[_i]), (PG8_LAS unsigned*)(lds + (bufoff) + ldsw + _i * 8192), 16, 0, 0); } while (0)
#define PG8_LDA(dst, b, h) do { _Pragma("unroll") for (int m = 0; m < 4; ++m) _Pragma("unroll") for (int k = 0; k < 2; ++k) dst[m][k] = *(const PG8_LAS bf16x8*)(lds + PG8_SA(b, h) + aoff + m * 2048 + k * 1024); } while (0)
#define PG8_LDB(dst, b, h) do { _Pragma("unroll") for (int n = 0; n < 2; ++n) _Pragma("unroll") for (int k = 0; k < 2; ++k) dst[n][k] = *(const PG8_LAS bf16x8*)(lds + PG8_SB(b, h) + boff + n * 2048 + k * 1024); } while (0)
#define PG8_MMA(ai, bj, At, Bt) do { __builtin_amdgcn_s_setprio(1); _Pragma("unroll") for (int m = 0; m < 4; ++m) _Pragma("unroll") for (int n = 0; n < 2; ++n) _Pragma("unroll") for (int k = 0; k < 2; ++k) \
        acc[ai][bj][m][n] = __builtin_amdgcn_mfma_f32_16x16x32_bf16(Bt[n][k], At[m][k], acc[ai][bj][m][n], 0, 0, 0); __builtin_amdgcn_s_setprio(0); } while (0)
#define PG8_WAIT_V(n) asm volatile("s_waitcnt vmcnt(" #n ")" ::: "memory")
#define PG8_WAIT_L(n) asm volatile("s_waitcnt lgkmcnt(" #n ")" ::: "memory")
#define PG8_BAR __builtin_amdgcn_s_barrier()
#define PG8_SCHED __builtin_amdgcn_sched_barrier(0)
    Unit cur, nxt; int ui = 0;
    if (!S.next(0, cur)) return;
    f32x4 acc[2][2][4][2];
#pragma unroll
    for (int a = 0; a < 2; ++a)
#pragma unroll
        for (int b = 0; b < 2; ++b)
#pragma unroll
            for (int m = 0; m < 4; ++m)
#pragma unroll
                for (int n = 0; n < 2; ++n) acc[a][b][m][n] = (f32x4){0.f, 0.f, 0.f, 0.f};
    bf16x8 At[4][2], B0[2][2], B1[2][2];
    const char* cA = (const char*)g.A + (size_t)cur.pm * tstep; const char* cB = (const char*)g.Bt + (size_t)cur.pn * tstep;
    S.a_ready(cur);
    if constexpr (SP2) {
        PG8_STAGE(PG8_SB(0, 0), cB, voffB); PG8_STAGE(PG8_SB(0, 1), cB + hstep, voffB); PG8_STAGE(PG8_SA(0, 0), cA, voffA); PG8_STAGE(PG8_SA(0, 1), cA + hstep, voffA);
        if (wr == 1) PG8_BAR;
        PG8_WAIT_V(2); PG8_BAR;
        PG8_STAGE(PG8_SB(1, 0), cB + kstep, voffB); PG8_STAGE(PG8_SA(1, 0), cA + kstep, voffA); PG8_STAGE(PG8_SB(1, 1), cB + hstep + kstep, voffB);
        PG8_WAIT_V(6); PG8_BAR;
    } else {
        PG8_STAGE(PG8_SB(0, 0), cB, voffB); PG8_STAGE(PG8_SA(0, 0), cA, voffA); PG8_STAGE(PG8_SB(0, 1), cB + hstep, voffB); PG8_STAGE(PG8_SA(0, 1), cA + hstep, voffA);
        if (wr == 1) PG8_BAR;
        PG8_WAIT_V(4); PG8_BAR;
        PG8_STAGE(PG8_SB(1, 0), cB + kstep, voffB); PG8_STAGE(PG8_SA(1, 0), cA + kstep, voffA); PG8_STAGE(PG8_SB(1, 1), cB + hstep + kstep, voffB);
        PG8_WAIT_V(6); PG8_BAR;
    }
    for (;;) {
        const bool has_next = S.next(ui + 1, nxt);
        const char* nA = has_next ? (const char*)g.A + (size_t)nxt.pm * tstep : cA; const char* nB = has_next ? (const char*)g.Bt + (size_t)nxt.pn * tstep : cB;
        for (int t = 0; t < nt; t += 2) {
            const bool last = (t == nt - 2);
            const char* a1 = cA + (size_t)(t + 1) * kstep;
            const char* a2 = last ? nA : cA + (size_t)(t + 2) * kstep; const char* b2 = last ? nB : cB + (size_t)(t + 2) * kstep;
            const char* a3 = a2 + kstep; const char* b3 = b2 + kstep;
            if (last && has_next) S.a_ready(nxt);
            if constexpr (SP2) {
            PG8_LDB(B0, 0, 0); PG8_LDB(B1, 0, 1); PG8_SCHED; PG8_LDA(At, 0, 0); PG8_STAGE(PG8_SA(1, 1), a1 + hstep, voffA);
            PG8_WAIT_V(8); PG8_WAIT_L(0); PG8_BAR; PG8_MMA(0, 0, At, B0); PG8_MMA(0, 1, At, B1); PG8_BAR; PG8_SCHED;
            PG8_LDA(At, 0, 1); PG8_STAGE(PG8_SB(0, 0), b2, voffB); PG8_STAGE(PG8_SB(0, 1), b2 + hstep, voffB); PG8_STAGE(PG8_SA(0, 0), a2, voffA);
            PG8_WAIT_V(8); PG8_WAIT_L(0); PG8_BAR; PG8_MMA(1, 0, At, B0); PG8_MMA(1, 1, At, B1); PG8_BAR; PG8_SCHED;
            PG8_LDB(B0, 1, 0); PG8_LDB(B1, 1, 1); PG8_SCHED; PG8_LDA(At, 1, 0); PG8_STAGE(PG8_SA(0, 1), a2 + hstep, voffA);
            PG8_WAIT_V(8); PG8_WAIT_L(0); PG8_BAR; PG8_MMA(0, 0, At, B0); PG8_MMA(0, 1, At, B1); PG8_BAR; PG8_SCHED;
            PG8_LDA(At, 1, 1); PG8_STAGE(PG8_SB(1, 0), b3, voffB); PG8_STAGE(PG8_SB(1, 1), b3 + hstep, voffB); PG8_STAGE(PG8_SA(1, 0), a3, voffA);
            PG8_WAIT_V(8); PG8_WAIT_L(0); PG8_BAR; PG8_MMA(1, 0, At, B0); PG8_MMA(1, 1, At, B1); PG8_BAR; PG8_SCHED;
            } else {
            PG8_LDB(B0, 0, 0); PG8_SCHED; PG8_LDA(At, 0, 0); PG8_STAGE(PG8_SA(1, 1), a1 + hstep, voffA);
            PG8_WAIT_L(8); PG8_BAR; PG8_WAIT_L(0); PG8_MMA(0, 0, At, B0); PG8_BAR; PG8_SCHED;
            PG8_LDB(B1, 0, 1); PG8_STAGE(PG8_SB(0, 0), b2, voffB);
            PG8_BAR; PG8_WAIT_L(0); PG8_MMA(0, 1, At, B1); PG8_BAR;
            PG8_LDA(At, 0, 1); PG8_STAGE(PG8_SA(0, 0), a2, voffA);
            PG8_BAR; PG8_WAIT_L(0); PG8_MMA(1, 0, At, B0); PG8_BAR; PG8_SCHED;
            PG8_STAGE(PG8_SB(0, 1), b2 + hstep, voffB);
            PG8_WAIT_V(6); PG8_BAR; PG8_MMA(1, 1, At, B1); PG8_BAR;
            PG8_LDB(B0, 1, 0); PG8_SCHED; PG8_LDA(At, 1, 0); PG8_STAGE(PG8_SA(0, 1), a2 + hstep, voffA);
            PG8_WAIT_L(8); PG8_BAR; PG8_WAIT_L(0); PG8_MMA(0, 0, At, B0); PG8_BAR; PG8_SCHED;
            PG8_LDB(B1, 1, 1); PG8_STAGE(PG8_SB(1, 0), b3, voffB);
            PG8_BAR; PG8_WAIT_L(0); PG8_MMA(0, 1, At, B1); PG8_BAR;
            PG8_LDA(At, 1, 1); PG8_STAGE(PG8_SA(1, 0), a3, voffA);
            PG8_BAR; PG8_WAIT_L(0); PG8_MMA(1, 0, At, B0); PG8_BAR; PG8_SCHED;
            PG8_STAGE(PG8_SB(1, 1), b3 + hstep, voffB);
            PG8_WAIT_V(6); PG8_BAR; PG8_MMA(1, 1, At, B1); PG8_BAR;
            }
        }
        if constexpr (ALIGN_EPI) { if (wr == 0) PG8_BAR; }
        if constexpr (!Epi::AFTER_DRAIN) { E(acc, cur, wr, wc, fr, fq); S.done(cur); }
        if (!has_next) break;
#pragma unroll
        for (int a = 0; a < 2; ++a)
#pragma unroll
            for (int b = 0; b < 2; ++b)
#pragma unroll
                for (int m = 0; m < 4; ++m)
#pragma unroll
                    for (int n = 0; n < 2; ++n) acc[a][b][m][n] = (f32x4){0.f, 0.f, 0.f, 0.f};
        cur = nxt; cA = nA; cB = nB; ++ui;
        if constexpr (ALIGN_EPI) { if (wr == 1) PG8_BAR; }
    }
    PG8_WAIT_V(0);
    if constexpr (!ALIGN_EPI) { if (wr == 0) PG8_BAR; }
    PG8_BAR;
    if constexpr (Epi::AFTER_DRAIN) { E.fused(acc, cur, wr, wc, fr, fq, lds, wid, lane); S.done(cur); }
#undef PG8_SA
#undef PG8_SB
#undef PG8_STAGE
#undef PG8_LDA
#undef PG8_LDB
#undef PG8_MMA
#undef PG8_WAIT_V
#undef PG8_WAIT_L
#undef PG8_BAR
#undef PG8_SCHED
}
}
#define GAS __attribute__((address_space(1)))
#define LAS __attribute__((address_space(3)))
typedef unsigned short bf16;
typedef unsigned v4u __attribute__((ext_vector_type(4)));
typedef float f32x4 __attribute__((ext_vector_type(4)));
typedef short bf16x8 __attribute__((ext_vector_type(8)));
typedef GAS unsigned gu32;
typedef GAS unsigned long long gu64;
#define RLX_AGENT __ATOMIC_RELAXED, __HIP_MEMORY_SCOPE_AGENT
#define LDS_WAIT() asm volatile("s_waitcnt lgkmcnt(0)" ::: "memory")
#define VM_WAIT() asm volatile("s_waitcnt vmcnt(0)" ::: "memory")
__device__ __forceinline__ unsigned long long rt() { return __builtin_amdgcn_s_memrealtime(); }
__device__ __forceinline__ unsigned f2bf(float f) { unsigned u = __builtin_bit_cast(unsigned, f); return (u + 0x7fffu + ((u >> 16) & 1u)) >> 16; }
__device__ __forceinline__ unsigned pk2(float lo, float hi) { return f2bf(lo) | (f2bf(hi) << 16); }

#define XB_TMO      128
#define XB_XCNT(j)  (256  + 64 * (j))
#define XB_XSUB(j)  (1280 + 64 * (j))
#define XB_XGEN(j)  (2304 + 64 * (j))
#define XB_TOP      3328
#define XB_TOPGEN   3392
#define XCD_BAR_WORDS 3456
#define XB_SPIN_CAP (1u << 18)

__device__ __forceinline__ unsigned xb_ld(unsigned* p)              { return __hip_atomic_load(p, __ATOMIC_RELAXED, __HIP_MEMORY_SCOPE_AGENT); }
__device__ __forceinline__ unsigned xb_add(unsigned* p, unsigned v) { return __hip_atomic_fetch_add(p, v, __ATOMIC_RELAXED, __HIP_MEMORY_SCOPE_AGENT); }
__device__ __forceinline__ unsigned xb_xcc_id() { return (unsigned)__builtin_amdgcn_s_getreg((3 << 11) | 20) & 0xFu; }
#define XB_SPIN(cond, bar) do { unsigned _sp = 0; while (cond) { __builtin_amdgcn_s_sleep(1); \
    if ((++_sp & 255u) == 0u) { if (xb_ld(&(bar)[XB_TMO])) break; if (_sp > XB_SPIN_CAP) { atomicAdd(&(bar)[XB_TMO], 1u); break; } } } } while (0)

struct XcdBarrier {
    unsigned* bar; unsigned x;
    volatile LAS unsigned* st;
};

__device__ __forceinline__ XcdBarrier xcd_barrier_post(unsigned* bar, volatile LAS unsigned* st, bool leader) {
    XcdBarrier b; b.bar = bar; b.x = xb_xcc_id(); b.st = st;
    if (leader) (void)xb_add(&bar[XB_XCNT(b.x)], 1u);
    return b;
}
__device__ __forceinline__ void xcd_barrier_complete(unsigned* bar, unsigned x, unsigned& nloc, unsigned& nx) {
    const unsigned G = gridDim.x * gridDim.y * gridDim.z;
    unsigned sum, cnt, mine, sp = 0u;
    for (;;) {
        sum = 0u; cnt = 0u; mine = 0u;
#pragma unroll
        for (unsigned j = 0; j < 16; ++j) { const unsigned c = xb_ld(&bar[XB_XCNT(j)]); sum += c; cnt += (c > 0u) ? 1u : 0u; mine = (j == x) ? c : mine; }
        if (sum == G) break;
        __builtin_amdgcn_s_sleep(1);
        if ((++sp & 255u) == 0u) { if (xb_ld(&bar[XB_TMO])) break; if (sp > XB_SPIN_CAP) { atomicAdd(&bar[XB_TMO], 1u); break; } }
    }
    nloc = mine > 0u ? mine : 1u; nx = cnt > 0u ? cnt : 1u;
}

__device__ __forceinline__ void xcd_barrier(const XcdBarrier& b, bool leader) {
    asm volatile("s_waitcnt vmcnt(0)" ::: "memory");
    __syncthreads();
    if (leader) {
        unsigned* bar = b.bar;
        __builtin_amdgcn_s_waitcnt(0);
        unsigned nloc = b.st[0], nx = b.st[1];
        if (nloc == 0u) { xcd_barrier_complete(bar, b.x, nloc, nx); b.st[0] = nloc; b.st[1] = nx; }
        const unsigned old = xb_add(&bar[XB_XSUB(b.x)], 1u);
        const unsigned gen = old / nloc;
        if (old + 1u == (gen + 1u) * nloc) {
            __builtin_amdgcn_fence(__ATOMIC_RELEASE, "agent");
            asm volatile("s_waitcnt vmcnt(0)" ::: "memory");
            const unsigned og = xb_add(&bar[XB_TOP], 1u);
            const unsigned tg = og / nx;
            if (og + 1u == (tg + 1u) * nx) xb_add(&bar[XB_TOPGEN], 1u);
            else XB_SPIN(xb_ld(&bar[XB_TOPGEN]) == tg, bar);
            __builtin_amdgcn_fence(__ATOMIC_ACQUIRE, "agent");
            xb_add(&bar[XB_XGEN(b.x)], 1u);
            asm volatile("s_waitcnt vmcnt(0)" ::: "memory");
        } else {
            XB_SPIN(xb_ld(&bar[XB_XGEN(b.x)]) == gen, bar);
            __builtin_amdgcn_fence(__ATOMIC_ACQUIRE, "agent");
            asm volatile("s_waitcnt vmcnt(0)" ::: "memory");
        }
    }
    __syncthreads();
}
constexpr int NB = 2, SEQ = 16384, NTOK = NB * SEQ, DM = 1024, NLAYER = 4;
constexpr int PROJW = 4616, PW = 4608;
constexpr int C_MLQK = 0, C_MLV = 1024, C_MLO = 1536, C_MLZ = 2048, C_ATQ = 2560, C_ATK = 3072, C_ATV = 3584, C_ATZ = 4096;
constexpr int SC = 256, NSC = SEQ / SC;
constexpr int NBLK = SEQ / 256;
constexpr float EPS = 1e-6f;
constexpr int NPH = 5;
constexpr int NGP = 1 + NLAYER * NPH;

constexpr size_t MiB = 1u << 20;
constexpr size_t OFF_CTL = 0, CTL_BYTES = 1 * MiB;
constexpr size_t OFF_WIN = 1 * MiB;
constexpr size_t OFF_WOUT = 37 * MiB;
constexpr size_t OFF_XN = 45 * MiB;
constexpr size_t OFF_GATES = 109 * MiB;
constexpr size_t OFF_PROJ = 110 * MiB;
constexpr size_t OFF_Y = 398 * MiB;
constexpr size_t OFF_CT = 462 * MiB;
constexpr size_t OFF_WG = 478 * MiB;
constexpr size_t OFF_SSQ = 479 * MiB;
constexpr size_t OFF_NL = 494 * MiB;
constexpr size_t OFF_KMEAN = 495 * MiB;
constexpr size_t OFF_SEL = 496 * MiB;
constexpr size_t WS_END = 501 * MiB;
constexpr int CW_BAR = 1024;

constexpr int LDS_BYTES = 147456, MISC_OFF = 143360;
constexpr size_t SECSZ = (size_t)NTOK * 512;
enum { S_MQ = 0, S_MK = 1, S_MV = 2, S_MO = 3, S_MZ = 4, S_AQ = 5, S_AK = 6, S_AV = 7, S_AZ = 8 };
__device__ __forceinline__ size_t ml_off(int sec, int b, int hh, int t) { return (size_t)sec * SECSZ + ((size_t)(b * 4 + hh) * SEQ + t) * 128; }
__device__ __forceinline__ size_t at_off(int sec, int b, int h, int t) { return (size_t)sec * SECSZ + ((size_t)(b * 8 + h) * SEQ + t) * 64; }

typedef unsigned u32x2 __attribute__((ext_vector_type(2)));
typedef float f32x2 __attribute__((ext_vector_type(2)));
#define DI __device__ __forceinline__

struct Params {
    const float* x; const float* norm_w; const float* w_in; const float* b_i; const float* b_f; const float* conv_w; const float* conv_b;
    const float* mnorm_w; const float* qn_w; const float* kn_w; const float* w_out;
    float* out; unsigned char* ws; int ph_lo, ph_hi;
};

DI float bf2f(unsigned short h) { return __uint_as_float((unsigned)h << 16); }
DI float bflo(unsigned w) { return __uint_as_float(w << 16); }
DI float bfhi(unsigned w) { return __uint_as_float(w & 0xffff0000u); }
DI float wave_sum(float v) {
#pragma unroll
    for (int o = 1; o < 64; o <<= 1) v += __shfl_xor(v, o);
    return v;
}
DI float wave_max(float v) {
#pragma unroll
    for (int o = 1; o < 64; o <<= 1) v = fmaxf(v, __shfl_xor(v, o));
    return v;
}
DI float scan_add(float v, int lane) {
#pragma unroll
    for (int o = 1; o < 64; o <<= 1) { const float t = __shfl_up(v, o); if (lane >= o) v += t; }
    return v;
}
DI float scan_max(float v, int lane) {
#pragma unroll
    for (int o = 1; o < 64; o <<= 1) { const float t = __shfl_up(v, o); if (lane >= o) v = fmaxf(v, t); }
    return v;
}
DI float silu_f(float v) { return v * __builtin_amdgcn_rcpf(1.0f + __builtin_amdgcn_exp2f(v * -1.4426950408889634f)); }
DI float logsigmoid_f(float f) { return fminf(f, 0.f) - log1pf(__expf(-fabsf(f))); }

struct Ctx { int tid, lane, wave, gw, ngw; LAS unsigned char* lds; };

DI void transpose_item(const float* W, int ldw, int col0, int K, bf16* WT, int row_off, LAS float* scr, int item, int nblk, int lane, const float* rowscale, int perm_lo = 0, int perm_hi = 0) {
    const int kb = item / nblk, nb = item % nblk, k0 = 64 * kb, n0 = 32 * nb;
    float tv[32];
#pragma unroll
    for (int i = 0; i < 32; ++i) { const int kk = 2 * i + (lane >> 5); tv[i] = W[(size_t)(k0 + kk) * ldw + col0 + n0 + (lane & 31)] * (rowscale ? rowscale[k0 + kk] : 1.0f); }
#pragma unroll
    for (int i = 0; i < 32; ++i) { const int kk = 2 * i + (lane >> 5); scr[kk * 33 + (lane & 31)] = tv[i]; }
    LDS_WAIT(); asm volatile("" ::: "memory");
    const int c = lane & 7;
#pragma unroll
    for (int j = 0; j < 4; ++j) { const int n = (lane >> 3) + 8 * j; const LAS float* s = scr + (8 * c) * 33 + n;
        v4u o; o.x = pk2(s[0 * 33], s[1 * 33]); o.y = pk2(s[2 * 33], s[3 * 33]); o.z = pk2(s[4 * 33], s[5 * 33]); o.w = pk2(s[6 * 33], s[7 * 33]);
        int orow = row_off + n0 + n;
        if (orow >= perm_lo && orow < perm_hi) orow = (orow & ~255) + 128 * ((orow & 63) >> 5) + 32 * ((orow & 255) >> 6) + (orow & 31);
        *(v4u*)(WT + (size_t)orow * K + k0 + 8 * c) = o; }
    LDS_WAIT(); asm volatile("" ::: "memory");
}
DI void ph_prologue(const Params& P, const Ctx& C) {
    LAS float* scr = (LAS float*)(C.lds + C.wave * 16384);
    constexpr int IA = 16 * 80, IB = 16 * 64, IO = 16 * 32, IL = IA + IB + IO;
    for (int it = C.gw; it < NLAYER * IL; it += C.ngw) {
        const int l = it / IL; int r = it % IL;
        const float* wi = P.w_in + (size_t)l * DM * PROJW; bf16* wt = (bf16*)(P.ws + OFF_WIN) + (size_t)l * PW * DM;
        if (r < IA) { transpose_item(wi, PROJW, 0, DM, wt, 0, scr, r, 80, C.lane, P.norm_w + l * DM); continue; } r -= IA;
        if (r < IB) { transpose_item(wi, PROJW, 2568, DM, wt, 2560, scr, r, 64, C.lane, P.norm_w + l * DM, C_ATQ, C_ATV); continue; } r -= IB;
        transpose_item(P.w_out + (size_t)l * DM * DM, DM, 0, DM, (bf16*)(P.ws + OFF_WOUT) + (size_t)l * DM * DM, 0, scr, r, 32, C.lane, nullptr);
    }
    bf16* WG = (bf16*)(P.ws + OFF_WG);
    for (int i = (C.gw >> 3) * 512 + C.tid; i < NLAYER * 32 * DM; i += (C.ngw >> 3) * 512) {
        const int k = i & (DM - 1), g = (i >> 10) & 31, l = i >> 15;
        WG[i] = (g < 8) ? (bf16)f2bf(P.w_in[((size_t)l * DM + k) * PROJW + 2560 + g] * P.norm_w[l * DM + k]) : (bf16)0;
    }
    bf16* XB = (bf16*)(P.ws + OFF_XN); float* SSQ = (float*)(P.ws + OFF_SSQ);
    for (int row0 = C.gw * 4; row0 < NTOK; row0 += C.ngw * 4) {
        f32x4 v[4][4];
#pragma unroll
        for (int r = 0; r < 4; ++r)
#pragma unroll
            for (int j = 0; j < 4; ++j) v[r][j] = ((const f32x4*)(P.x + (size_t)(row0 + r) * DM) + C.lane)[64 * j];
#pragma unroll
        for (int r = 0; r < 4; ++r) {
            unsigned long long* o8 = (unsigned long long*)(XB + (size_t)(row0 + r) * DM) + C.lane; float ss = 0.f;
#pragma unroll
            for (int j = 0; j < 4; ++j) { const f32x4 x = v[r][j]; ss += (x.x * x.x + x.y * x.y) + (x.z * x.z + x.w * x.w); o8[64 * j] = (unsigned long long)pk2(x.x, x.y) | ((unsigned long long)pk2(x.z, x.w) << 32); }
            ss = wave_sum(ss);
            if (C.lane < 16) SSQ[(size_t)(row0 + r) * 16 + C.lane] = C.lane == 0 ? ss : 0.f;
        }
    }
}

DI void ph_norm(const Params& P, const Ctx& C, int layer, const float* xin) {
    const int lane = C.lane;
    LAS f32x4* wgl = (LAS f32x4*)C.lds;
    { const float* wl = P.w_in + (size_t)layer * DM * PROJW + 2560;
      for (int i = C.tid; i < 2048; i += 512) wgl[i] = *(const f32x4*)(wl + (size_t)(i >> 1) * PROJW + 4 * (i & 1)); }
    __syncthreads();
    f32x4 nw[4];
#pragma unroll
    for (int j = 0; j < 4; ++j) nw[j] = *(const f32x4*)(P.norm_w + layer * DM + 256 * j + 4 * lane);
    float bias = 0.f; if (lane < 4) bias = P.b_i[layer * 4 + lane]; else if (lane < 8) bias = P.b_f[layer * 4 + lane - 4];
    bf16* XN = (bf16*)(P.ws + OFF_XN); float* G = (float*)(P.ws + OFF_GATES);
    for (int row = C.gw; row < NTOK; row += C.ngw) {
        const f32x4* xr = (const f32x4*)(xin + (size_t)row * DM) + lane;
        f32x4 v[4]; float ss = 0.f;
#pragma unroll
        for (int j = 0; j < 4; ++j) { v[j] = xr[64 * j]; ss += (v[j].x * v[j].x + v[j].y * v[j].y) + (v[j].z * v[j].z + v[j].w * v[j].w); }
        const float rstd = rsqrtf(wave_sum(ss) * (1.f / DM) + EPS);
        f32x4 g0 = {0.f, 0.f, 0.f, 0.f}, g1 = {0.f, 0.f, 0.f, 0.f};
        unsigned long long* o8 = (unsigned long long*)(XN + (size_t)row * DM) + lane;
#pragma unroll
        for (int j = 0; j < 4; ++j) { const f32x4 h = v[j] * rstd * nw[j];
            o8[64 * j] = (unsigned long long)pk2(h.x, h.y) | ((unsigned long long)pk2(h.z, h.w) << 32);
#pragma unroll
            for (int c = 0; c < 4; ++c) { const int k = 256 * j + 4 * lane + c; g0 += wgl[2 * k] * h[c]; g1 += wgl[2 * k + 1] * h[c]; } }
        float gs[8];
#pragma unroll
        for (int i = 0; i < 4; ++i) { gs[i] = wave_sum(g0[i]); gs[4 + i] = wave_sum(g1[i]); }
        float mine = 0.f;
#pragma unroll
        for (int i = 0; i < 8; ++i) if (lane == i) mine = gs[i];
        if (lane < 8) G[(size_t)row * 8 + lane] = mine + bias;
    }
    __syncthreads();
}

DI void ph_conv_qknorm(const Params& P, const Ctx& C, int layer) {
    const int lane = C.lane;
    bf16* PR = (bf16*)(P.ws + OFF_PROJ); bf16* QKC = (bf16*)(P.ws + OFF_XN);
    float qw[8], kw[8];
#pragma unroll
    for (int i = 0; i < 8; ++i) { qw[i] = P.qn_w[layer * 64 + (lane & 7) * 8 + i]; kw[i] = P.kn_w[layer * 64 + (lane & 7) * 8 + i]; }
    for (int tok = C.gw; tok < NTOK; tok += C.ngw) {
        const int t = tok & (SEQ - 1);
#pragma unroll
        for (int it = 0; it < 2; ++it) {
            const int c = it * 512 + lane * 8;
            float a[8];
#pragma unroll
            for (int i = 0; i < 8; ++i) a[i] = P.conv_b[layer * 1024 + c + i];
#pragma unroll
            for (int k = 0; k < 4; ++k) {
                if (t - 3 + k >= 0) {
                    const v4u xv = *(const v4u*)(PR + (size_t)(tok - 3 + k) * PW + C_MLQK + c);
                    const float* w = P.conv_w + ((size_t)layer * 4 + k) * 1024 + c;
                    a[0] += w[0] * bflo(xv.x); a[1] += w[1] * bfhi(xv.x); a[2] += w[2] * bflo(xv.y); a[3] += w[3] * bfhi(xv.y);
                    a[4] += w[4] * bflo(xv.z); a[5] += w[5] * bfhi(xv.z); a[6] += w[6] * bflo(xv.w); a[7] += w[7] * bfhi(xv.w);
                }
            }
            v4u o; o.x = pk2(silu_f(a[0]), silu_f(a[1])); o.y = pk2(silu_f(a[2]), silu_f(a[3])); o.z = pk2(silu_f(a[4]), silu_f(a[5])); o.w = pk2(silu_f(a[6]), silu_f(a[7]));
            *(v4u*)(QKC + (size_t)tok * 1024 + c) = o;
        }
#pragma unroll
        for (int which = 0; which < 2; ++which) {
            bf16* p = PR + (size_t)tok * PW + (which ? C_ATK : C_ATQ) + lane * 8;
            const v4u xv = *(const v4u*)p;
            float v[8] = {bflo(xv.x), bfhi(xv.x), bflo(xv.y), bfhi(xv.y), bflo(xv.z), bfhi(xv.z), bflo(xv.w), bfhi(xv.w)};
            float ss = 0.f;
#pragma unroll
            for (int i = 0; i < 8; ++i) ss += v[i] * v[i];
            ss += __shfl_xor(ss, 1); ss += __shfl_xor(ss, 2); ss += __shfl_xor(ss, 4);
            const float r = rsqrtf(ss * (1.f / 64.f) + EPS);
#pragma unroll
            for (int i = 0; i < 8; ++i) v[i] = v[i] * r * (which ? kw[i] : qw[i]);
            v4u o; o.x = pk2(v[0], v[1]); o.y = pk2(v[2], v[3]); o.z = pk2(v[4], v[5]); o.w = pk2(v[6], v[7]);
            *(v4u*)p = o;
        }
    }
}

DI void gate_scalars(const float* G, int tok0, int hh, int lane, float (&bb)[4], float (&aa)[4]) {
    float lf[4], ii[4];
#pragma unroll
    for (int j = 0; j < 4; ++j) { const float* g = G + (size_t)(tok0 + 4 * lane + j) * 8; ii[j] = g[hh]; lf[j] = logsigmoid_f(g[4 + hh]); }
    lf[1] += lf[0]; lf[2] += lf[1]; lf[3] += lf[2];
    const float incl = scan_add(lf[3], lane), excl = incl - lf[3];
#pragma unroll
    for (int j = 0; j < 4; ++j) { bb[j] = excl + lf[j]; aa[j] = ii[j] - bb[j]; }
}

DI void ph_cloc_kmean(const Params& P, const Ctx& C) {
    const int lane = C.lane;
    const bf16* PR = (const bf16*)(P.ws + OFF_PROJ); const bf16* QKC = (const bf16*)(P.ws + OFF_XN); const float* G = (const float*)(P.ws + OFF_GATES);
    float* CT = (float*)(P.ws + OFF_CT); float* NL = (float*)(P.ws + OFF_NL); float* MLOC = NL + 8 * 64 * 128; float* BLAST = MLOC + 512;
    LAS float* wts = (LAS float*)(C.lds + C.wave * 16384);
    for (int it = C.gw; it < 8 * NSC * 16; it += C.ngw) {
        const int eg = it & 15, unit = it >> 4, sc = unit & 63, bh = unit >> 6, b = bh >> 2, hh = bh & 3;
        const int tok0 = b * SEQ + sc * SC;
        float bb[4], aa[4]; gate_scalars(G, tok0, hh, lane, bb, aa);
        const float A = wave_max(fmaxf(fmaxf(aa[0], aa[1]), fmaxf(aa[2], aa[3])));
        const float blast = __shfl(bb[3], 63);
#pragma unroll
        for (int j = 0; j < 4; ++j) wts[4 * lane + j] = __expf(aa[j] - A);
        LDS_WAIT(); asm volatile("" ::: "memory");
        float acc[8][2]; float nacc[2] = {0.f, 0.f};
#pragma unroll
        for (int e = 0; e < 8; ++e) { acc[e][0] = 0.f; acc[e][1] = 0.f; }
        for (int t = 0; t < SC; ++t) {
            const unsigned kk = *(const unsigned*)(QKC + (size_t)(tok0 + t) * 1024 + 512 + hh * 128 + 2 * lane);
            const v4u vv = *(const v4u*)(PR + (size_t)(tok0 + t) * PW + C_MLV + hh * 128 + eg * 8);
            const float w = wts[t]; const float k0 = bflo(kk) * w, k1 = bfhi(kk) * w;
            const float ve[8] = {bflo(vv.x), bfhi(vv.x), bflo(vv.y), bfhi(vv.y), bflo(vv.z), bfhi(vv.z), bflo(vv.w), bfhi(vv.w)};
#pragma unroll
            for (int e = 0; e < 8; ++e) { acc[e][0] += k0 * ve[e]; acc[e][1] += k1 * ve[e]; }
            nacc[0] += k0; nacc[1] += k1;
        }
#pragma unroll
        for (int e = 0; e < 8; ++e) *(f32x2*)(CT + ((size_t)unit * 128 + eg * 8 + e) * 128 + 2 * lane) = (f32x2){acc[e][0], acc[e][1]};
        if (eg == 0) { *(f32x2*)(NL + (size_t)unit * 128 + 2 * lane) = (f32x2){nacc[0], nacc[1]}; if (lane == 0) { MLOC[unit] = blast + A; BLAST[unit] = blast; } }
        LDS_WAIT(); asm volatile("" ::: "memory");
    }
    float* KM = (float*)(P.ws + OFF_KMEAN);
    for (int it = C.gw; it < NB * 8 * NBLK; it += C.ngw) {
        const int n = it & 63, h = (it >> 6) & 7, b = it >> 9;
        const bf16* kp = PR + (size_t)(b * SEQ + n * 256) * PW + C_ATK + h * 64 + lane;
        float s = 0.f;
        for (int r = 0; r < 256; ++r) s += bf2f(kp[(size_t)r * PW]);
        KM[(size_t)it * 64 + lane] = s * (1.f / 256.f);
    }
}

template <bool DO_SCAN, bool DO_SEL> DI void ph_scan_select(const Params& P, const Ctx& C) {
    float* CT = (float*)(P.ws + OFF_CT); float* NL = (float*)(P.ws + OFF_NL); float* MLOC = NL + 8 * 64 * 128; float* BLAST = MLOC + 512; float* MPREV = BLAST + 512;
    const int gt = (C.gw >> 3) * 512 + C.tid, ngt = (C.ngw >> 3) * 512;
    if constexpr (DO_SCAN)
    for (int idx = gt; idx < 8 * (16384 + 128); idx += ngt) {
        const int bh = idx / 16512, r = idx % 16512;
        float* ptr; int stride;
        if (r < 16384) { ptr = CT + (size_t)bh * 64 * 16384 + r; stride = 16384; } else { ptr = NL + (size_t)bh * 64 * 128 + (r - 16384); stride = 128; }
        float c = 0.f, m = 0.f;
        for (int s0 = 0; s0 < NSC; s0 += 8) {
            float cl[8];
#pragma unroll
            for (int i = 0; i < 8; ++i) cl[i] = ptr[(size_t)(s0 + i) * stride];
#pragma unroll
            for (int i = 0; i < 8; ++i) {
                const float ml = MLOC[bh * 64 + s0 + i], bl = BLAST[bh * 64 + s0 + i];
                ptr[(size_t)(s0 + i) * stride] = c;
                if (r == 0) MPREV[bh * 64 + s0 + i] = m;
                const float mn = fmaxf(bl + m, ml);
                c = __expf(bl + m - mn) * c + __expf(ml - mn) * cl[i];
                m = mn;
            }
        }
    }
    const bf16* PR = (const bf16*)(P.ws + OFF_PROJ); const float* KM = (const float*)(P.ws + OFF_KMEAN); int* SEL = (int*)(P.ws + OFF_SEL);
    if constexpr (DO_SEL)
    for (int idx = gt; idx < NTOK * 8; idx += ngt) {
        const int tok = idx >> 3, h = idx & 7, b = tok >> 14, t = tok & (SEQ - 1), j = t >> 8;
        float q[64];
        const v4u* qp = (const v4u*)(PR + (size_t)tok * PW + C_ATQ + h * 64);
#pragma unroll
        for (int i = 0; i < 8; ++i) { const v4u w = qp[i]; q[8 * i] = bflo(w.x); q[8 * i + 1] = bfhi(w.x); q[8 * i + 2] = bflo(w.y); q[8 * i + 3] = bfhi(w.y); q[8 * i + 4] = bflo(w.z); q[8 * i + 5] = bfhi(w.z); q[8 * i + 6] = bflo(w.w); q[8 * i + 7] = bfhi(w.w); }
        float v0 = -INFINITY, v1 = -INFINITY, v2 = -INFINITY; int i0 = -1, i1 = -1, i2 = -1;
        const float* km = KM + (size_t)((b * 8 + h) * 64) * 64;
        for (int n = 0; n < j; ++n) {
            const f32x4* kp = (const f32x4*)(km + n * 64);
            float d = 0.f;
#pragma unroll
            for (int i = 0; i < 16; ++i) { const f32x4 kv = kp[i]; d += q[4 * i] * kv.x + q[4 * i + 1] * kv.y + q[4 * i + 2] * kv.z + q[4 * i + 3] * kv.w; }
            if (d > v0) { v2 = v1; i2 = i1; v1 = v0; i1 = i0; v0 = d; i0 = n; }
            else if (d > v1) { v2 = v1; i2 = i1; v1 = d; i1 = n; }
            else if (d > v2) { v2 = d; i2 = n; }
        }
        *(int4*)(SEL + (size_t)idx * 4) = make_int4(i0, i1, i2, -1);
    }
}

template <bool DO_ML, bool DO_AT> DI void ph_mixers(const Params& P, const Ctx& C, int layer) {
    const int lane = C.lane;
    const bf16* PR = (const bf16*)(P.ws + OFF_PROJ); const bf16* QKC = (const bf16*)(P.ws + OFF_XN); const float* G = (const float*)(P.ws + OFF_GATES);
    const float* CT = (const float*)(P.ws + OFF_CT); const float* NL = (const float*)(P.ws + OFF_NL); const float* MPREV = NL + 8 * 64 * 128 + 1024;
    bf16* Y = (bf16*)(P.ws + OFF_Y);
    LAS float* sa = (LAS float*)(C.lds + C.wave * 16384);
    LAS float* sM = sa + 256;
    LAS float* sb = sa + 512;
    LAS float* sq = sa + 768;
    if constexpr (DO_ML)
    for (int it = C.gw; it < 8 * NSC * 8; it += C.ngw) {
        const int tg = it & 7, unit = it >> 3, sc = unit & 63, bh = unit >> 6, b = bh >> 2, hh = bh & 3;
        const int tok0 = b * SEQ + sc * SC;
        float bb[4], aa[4]; gate_scalars(G, tok0, hh, lane, bb, aa);
        const float mprev = MPREV[unit];
        float cm[4]; cm[0] = aa[0]; cm[1] = fmaxf(cm[0], aa[1]); cm[2] = fmaxf(cm[1], aa[2]); cm[3] = fmaxf(cm[2], aa[3]);
        const float incl = scan_max(cm[3], lane); float excl = __shfl_up(incl, 1); if (lane == 0) excl = -INFINITY;
#pragma unroll
        for (int j = 0; j < 4; ++j) { sa[4 * lane + j] = aa[j]; sb[4 * lane + j] = bb[j]; sM[4 * lane + j] = fmaxf(mprev, fmaxf(excl, cm[j])); }
        LDS_WAIT(); asm volatile("" ::: "memory");
        const float* ct = CT + (size_t)unit * 16384; const f32x2 nprev = *(const f32x2*)(NL + (size_t)unit * 128 + 2 * lane);
        const f32x2 mw = *(const f32x2*)(P.mnorm_w + layer * 512 + hh * 128 + 2 * lane);
        for (int tl = tg * 32; tl < tg * 32 + 32; ++tl) {
            const int tok = tok0 + tl;
            const unsigned qq = *(const unsigned*)(QKC + (size_t)tok * 1024 + hh * 128 + 2 * lane);
            const float q0 = bflo(qq) * 0.08838834764831845f, q1 = bfhi(qq) * 0.08838834764831845f;
            sq[2 * lane] = q0; sq[2 * lane + 1] = q1;
            const float Mt = sM[tl], bt = sb[tl];
            float n0 = 0.f, n1 = 0.f, den = 0.f;
            for (int s = 0; s <= tl; ++s) {
                const unsigned kk = *(const unsigned*)(QKC + (size_t)(tok0 + s) * 1024 + 512 + hh * 128 + 2 * lane);
                const unsigned vv = *(const unsigned*)(PR + (size_t)(tok0 + s) * PW + C_MLV + hh * 128 + 2 * lane);
                const float dot = wave_sum(q0 * bflo(kk) + q1 * bfhi(kk));
                const float sv = dot * __expf(sa[s] - Mt);
                den += sv; n0 += sv * bflo(vv); n1 += sv * bfhi(vv);
            }
            LDS_WAIT(); asm volatile("" ::: "memory");
            float c0 = 0.f, c1 = 0.f;
            const f32x4* r0 = (const f32x4*)(ct + (size_t)(2 * lane) * 128); const f32x4* r1 = (const f32x4*)(ct + (size_t)(2 * lane + 1) * 128);
#pragma unroll 8
            for (int d4 = 0; d4 < 32; ++d4) { const f32x4 a = r0[d4], bq = r1[d4]; const float qa = sq[4 * d4], qb = sq[4 * d4 + 1], qc = sq[4 * d4 + 2], qd = sq[4 * d4 + 3];
                c0 += qa * a.x + qb * a.y + qc * a.z + qd * a.w; c1 += qa * bq.x + qb * bq.y + qc * bq.z + qd * bq.w; }
            const float qn = wave_sum(q0 * nprev.x + q1 * nprev.y);
            const float si = __expf(mprev - Mt);
            n0 += si * c0; n1 += si * c1; den += si * qn;
            const float dn = fmaxf(fabsf(den), __expf(-(bt + Mt)));
            const unsigned oo = *(const unsigned*)(PR + (size_t)tok * PW + C_MLO + hh * 128 + 2 * lane);
            const unsigned zz = *(const unsigned*)(PR + (size_t)tok * PW + C_MLZ + hh * 128 + 2 * lane);
            const float h0 = bflo(oo) * n0 / dn, h1 = bfhi(oo) * n1 / dn;
            const float r = rsqrtf(wave_sum(h0 * h0 + h1 * h1) * (1.f / 128.f) + EPS);
            *(unsigned*)(Y + (size_t)tok * 1024 + hh * 128 + 2 * lane) = pk2(h0 * r * mw.x * bflo(zz), h1 * r * mw.y * bfhi(zz));
            LDS_WAIT(); asm volatile("" ::: "memory");
        }
    }
    const int* SEL = (const int*)(P.ws + OFF_SEL);
    if constexpr (DO_AT)
    for (int it = C.gw; it < NTOK * 8; it += C.ngw) {
        const int tok = it >> 3, h = it & 7, b = tok >> 14, t = tok & (SEQ - 1), j = t >> 8;
        const float slope = exp2f(-(float)(h + 1));
        float q[64];
        const v4u* qp = (const v4u*)(PR + (size_t)tok * PW + C_ATQ + h * 64);
#pragma unroll
        for (int i = 0; i < 8; ++i) { const v4u w = qp[i]; q[8 * i] = bflo(w.x); q[8 * i + 1] = bfhi(w.x); q[8 * i + 2] = bflo(w.y); q[8 * i + 3] = bfhi(w.y); q[8 * i + 4] = bflo(w.z); q[8 * i + 5] = bfhi(w.z); q[8 * i + 6] = bflo(w.w); q[8 * i + 7] = bfhi(w.w); }
        const int4 sel = *(const int4*)(SEL + (size_t)it * 4);
        float m = -1e30f, l = 0.f, o = 0.f;
        for (int bi = 0; bi < 4; ++bi) {
            const int n = bi == 0 ? sel.x : bi == 1 ? sel.y : bi == 2 ? sel.z : j;
            if (n < 0) continue;
            const int nst = (bi == 3) ? ((t & 255) >> 6) + 1 : 4;
            for (int st = 0; st < nst; ++st) {
                const int s = n * 256 + st * 64 + lane;
                const v4u* kp = (const v4u*)(PR + (size_t)(b * SEQ + s) * PW + C_ATK + h * 64);
                float d = 0.f;
#pragma unroll
                for (int i = 0; i < 8; ++i) { const v4u w = kp[i]; d += q[8 * i] * bflo(w.x) + q[8 * i + 1] * bfhi(w.x) + q[8 * i + 2] * bflo(w.y) + q[8 * i + 3] * bfhi(w.y) + q[8 * i + 4] * bflo(w.z) + q[8 * i + 5] * bfhi(w.z) + q[8 * i + 6] * bflo(w.w) + q[8 * i + 7] * bfhi(w.w); }
                float scv = d * 0.125f - slope * (float)(t - s);
                if (s > t) scv = -INFINITY;
                const float mn = fmaxf(m, wave_max(scv));
                const float p = __expf(scv - mn), corr = __expf(m - mn);
                l = l * corr + wave_sum(p); o *= corr; m = mn;
                const bf16* vp = PR + (size_t)(b * SEQ + n * 256 + st * 64) * PW + C_ATV + h * 64 + lane;
#pragma unroll 8
                for (int kk = 0; kk < 64; ++kk) o += __shfl(p, kk) * bf2f(vp[(size_t)kk * PW]);
            }
        }
        const float z = bf2f(PR[(size_t)tok * PW + C_ATZ + h * 64 + lane]);
        Y[(size_t)tok * 1024 + 512 + h * 64 + lane] = (bf16)f2bf(o / l * z);
    }
}

typedef float f32x16 __attribute__((ext_vector_type(16)));
typedef short s16x4 __attribute__((ext_vector_type(4)));
typedef __bf16 bf16x2_t __attribute__((ext_vector_type(2)));
#define MFMA32(a, b, c) __builtin_amdgcn_mfma_f32_32x32x16_bf16((a), (b), (c), 0, 0, 0)
constexpr int LDS_IMGK = 0, LDS_IMGV = 65536, LDS_SCAL = 131072;
constexpr float ML_SCALE = 0.08838834764831845f;

DI int crow(int i, int h) { return (i & 3) + 8 * (i >> 2) + 4 * h; }
DI unsigned cvtpk(float lo, float hi) { f32x2 v = {lo, hi}; bf16x2_t b = __builtin_convertvector(v, bf16x2_t); return __builtin_bit_cast(unsigned, b); }
DI bf16x8 pack8(float a0, float a1, float a2, float a3, float a4, float a5, float a6, float a7) { v4u w; w.x = cvtpk(a0, a1); w.y = cvtpk(a2, a3); w.z = cvtpk(a4, a5); w.w = cvtpk(a6, a7); return __builtin_bit_cast(bf16x8, w); }
DI int img_off(int row, int ch) { return 256 * row + 16 * (ch ^ (((row & 3) << 2) | ((row >> 2) & 3))); }
DI s16x4 tr_read(const LAS unsigned char* p) { return __builtin_bit_cast(s16x4, __builtin_amdgcn_ds_read_tr16_b64_v4i16((LAS s16x4*)p)); }
DI bf16x8 tr_frag(const LAS unsigned char* img, int lane, int c, int rlo, int rhi) {
    const int blk = (lane >> 4) & 1, q = (lane & 15) >> 2, p = lane & 3, ch = 4 * c + 2 * blk + (p >> 1), sub = 8 * (p & 1);
    const s16x4 lo = tr_read(img + img_off(rlo + q, ch) + sub), hi = tr_read(img + img_off(rhi + q, ch) + sub);
    return __builtin_shufflevector(lo, hi, 0, 1, 2, 3, 4, 5, 6, 7);
}
template <bool SCALE> DI void stage_tile(LAS unsigned char* img, const bf16* g, int pitch, int tid, const LAS float* wrow) {
    v4u v[8];
#pragma unroll
    for (int i = 0; i < 8; ++i) { const int id = tid + 512 * i, row = id >> 4, ch = id & 15; v[i] = *(const v4u*)(g + (size_t)row * pitch + ch * 8); }
#pragma unroll
    for (int i = 0; i < 8; ++i) { const int id = tid + 512 * i, row = id >> 4, ch = id & 15; v4u x = v[i];
        if (SCALE) { const float w = wrow[row]; x.x = cvtpk(bflo(x.x) * w, bfhi(x.x) * w); x.y = cvtpk(bflo(x.y) * w, bfhi(x.y) * w); x.z = cvtpk(bflo(x.z) * w, bfhi(x.z) * w); x.w = cvtpk(bflo(x.w) * w, bfhi(x.w) * w); }
        *(LAS v4u*)(img + img_off(row, ch)) = x; }
}

template <bool SCALE> DI void stage_tile_conv(LAS unsigned char* img, const bf16* graw, const float* cw, const float* cb, bool first, int tid, const LAS float* wrow) {
    const int ch = tid & 15, r0 = (tid >> 4) * 8;
    float w[4][8], bias[8];
#pragma unroll
    for (int k = 0; k < 4; ++k) { const f32x4 a = *(const f32x4*)(cw + k * 1024 + ch * 8), b = *(const f32x4*)(cw + k * 1024 + ch * 8 + 4);
        w[k][0] = a.x; w[k][1] = a.y; w[k][2] = a.z; w[k][3] = a.w; w[k][4] = b.x; w[k][5] = b.y; w[k][6] = b.z; w[k][7] = b.w; }
    { const f32x4 a = *(const f32x4*)(cb + ch * 8), b = *(const f32x4*)(cb + ch * 8 + 4); bias[0] = a.x; bias[1] = a.y; bias[2] = a.z; bias[3] = a.w; bias[4] = b.x; bias[5] = b.y; bias[6] = b.z; bias[7] = b.w; }
    const bf16* gp = graw + (size_t)r0 * 128 + ch * 8;
    v4u x[7];
#pragma unroll
    for (int i = 0; i < 3; ++i) { const int rr = r0 - 3 + i; if (first && rr < 0) x[i] = (v4u){0u, 0u, 0u, 0u}; else x[i] = *(const v4u*)(gp + (ptrdiff_t)(i - 3) * 128); }
#pragma unroll 1
    for (int half = 0; half < 2; ++half) {
#pragma unroll
        for (int i = 0; i < 4; ++i) x[3 + i] = *(const v4u*)(gp + (ptrdiff_t)(4 * half + i) * 128);
#pragma unroll
        for (int i = 0; i < 4; ++i) {
            float a[8];
#pragma unroll
            for (int c = 0; c < 8; ++c) a[c] = bias[c];
#pragma unroll
            for (int k = 0; k < 4; ++k) { const v4u xv = x[i + k];
                a[0] += w[k][0] * bflo(xv.x); a[1] += w[k][1] * bfhi(xv.x); a[2] += w[k][2] * bflo(xv.y); a[3] += w[k][3] * bfhi(xv.y);
                a[4] += w[k][4] * bflo(xv.z); a[5] += w[k][5] * bfhi(xv.z); a[6] += w[k][6] * bflo(xv.w); a[7] += w[k][7] * bfhi(xv.w); }
            const int row = r0 + 4 * half + i; const float sc = SCALE ? wrow[row] : 1.0f;
            v4u o; o.x = cvtpk(silu_f(a[0]) * sc, silu_f(a[1]) * sc); o.y = cvtpk(silu_f(a[2]) * sc, silu_f(a[3]) * sc); o.z = cvtpk(silu_f(a[4]) * sc, silu_f(a[5]) * sc); o.w = cvtpk(silu_f(a[6]) * sc, silu_f(a[7]) * sc);
            *(LAS v4u*)(img + img_off(row, ch)) = o;
        }
        x[0] = x[4]; x[1] = x[5]; x[2] = x[6];
    }
}

DI void stage_tile_load(v4u (&v)[8], const bf16* g, int pitch, int tid) {
#pragma unroll
    for (int i = 0; i < 8; ++i) { const int id = tid + 512 * i, row = id >> 4, ch = id & 15; v[i] = *(const v4u*)(g + (size_t)row * pitch + ch * 8); }
}
DI void stage_tile_store(LAS unsigned char* img, const v4u (&v)[8], int tid) {
#pragma unroll
    for (int i = 0; i < 8; ++i) { const int id = tid + 512 * i, row = id >> 4, ch = id & 15; *(LAS v4u*)(img + img_off(row, ch)) = v[i]; }
}
DI void stage_conv_load(v4u (&x)[11], const bf16* graw, bool first, int tid) {
    const int ch = tid & 15, r0 = (tid >> 4) * 8; const bf16* gp = graw + (size_t)r0 * 128 + ch * 8;
#pragma unroll
    for (int i = 0; i < 11; ++i) { const int rr = r0 - 3 + i; if (first && rr < 0) x[i] = (v4u){0u, 0u, 0u, 0u}; else x[i] = *(const v4u*)(gp + (ptrdiff_t)(i - 3) * 128); }
}
DI void stage_conv_store(LAS unsigned char* img, const v4u (&x)[11], const float* cw, const float* cb, int tid) {
    const int ch = tid & 15, r0 = (tid >> 4) * 8;
    float w[4][8], bias[8];
#pragma unroll
    for (int k = 0; k < 4; ++k) { const f32x4 a = *(const f32x4*)(cw + k * 1024 + ch * 8), b = *(const f32x4*)(cw + k * 1024 + ch * 8 + 4);
        w[k][0] = a.x; w[k][1] = a.y; w[k][2] = a.z; w[k][3] = a.w; w[k][4] = b.x; w[k][5] = b.y; w[k][6] = b.z; w[k][7] = b.w; }
    { const f32x4 a = *(const f32x4*)(cb + ch * 8), b = *(const f32x4*)(cb + ch * 8 + 4); bias[0] = a.x; bias[1] = a.y; bias[2] = a.z; bias[3] = a.w; bias[4] = b.x; bias[5] = b.y; bias[6] = b.z; bias[7] = b.w; }
#pragma unroll
    for (int i = 0; i < 8; ++i) {
        float a[8];
#pragma unroll
        for (int c = 0; c < 8; ++c) a[c] = bias[c];
#pragma unroll
        for (int k = 0; k < 4; ++k) { const v4u xv = x[i + k];
            a[0] += w[k][0] * bflo(xv.x); a[1] += w[k][1] * bfhi(xv.x); a[2] += w[k][2] * bflo(xv.y); a[3] += w[k][3] * bfhi(xv.y);
            a[4] += w[k][4] * bflo(xv.z); a[5] += w[k][5] * bfhi(xv.z); a[6] += w[k][6] * bflo(xv.w); a[7] += w[k][7] * bfhi(xv.w); }
        v4u o; o.x = cvtpk(silu_f(a[0]), silu_f(a[1])); o.y = cvtpk(silu_f(a[2]), silu_f(a[3])); o.z = cvtpk(silu_f(a[4]), silu_f(a[5])); o.w = cvtpk(silu_f(a[6]), silu_f(a[7]));
        *(LAS v4u*)(img + img_off(r0 + i, ch)) = o;
    }
}

typedef float f32x4m __attribute__((ext_vector_type(4)));
DI void ph_gates_mfma(const Params& P, const Ctx& C, int layer) {
    const int wave = C.wave, bid = C.gw >> 3, nb = C.ngw >> 3;
    const bf16* XB = (const bf16*)(P.ws + OFF_XN); const bf16* WG = (const bf16*)(P.ws + OFF_WG) + (size_t)layer * 32 * DM; const float* SSQ = (const float*)(P.ws + OFF_SSQ); float* G = (float*)(P.ws + OFF_GATES);
    { const int tid = C.tid;
#pragma unroll
      for (int i = 0; i < 4; ++i) { const int id = tid + 512 * i, row = id >> 7, ch = id & 127; *(LAS v4u*)(C.lds + row * 2048 + 16 * (ch ^ row)) = *(const v4u*)(WG + (size_t)row * DM + ch * 8); } }
    __syncthreads();
    for (int unit = bid; unit < NTOK / 128; unit += nb) {
        int lane = C.lane; asm volatile("" : "+v"(lane));
        const int r16 = lane & 15, kq = lane >> 4, tokb = unit * 128 + 16 * wave;
        const bf16* ap = XB + (size_t)(tokb + r16) * DM + 8 * kq;
        f32x4m acc = {0.f, 0.f, 0.f, 0.f};
#pragma unroll 16
        for (int ks = 0; ks < 32; ++ks) {
            const bf16x8 a = *(const bf16x8*)(ap + 32 * ks);
            const bf16x8 bfr = *(const LAS bf16x8*)(C.lds + r16 * 2048 + 16 * ((4 * ks + kq) ^ r16));
            acc = __builtin_amdgcn_mfma_f32_16x16x32_bf16(a, bfr, acc, 0, 0, 0);
        }
        const f32x4* sp = (const f32x4*)(SSQ + (size_t)(tokb + r16) * 16); const f32x4 s0 = sp[0], s1 = sp[1], s2 = sp[2], s3 = sp[3];
        const float tt = ((s0[0] + s0[1]) + (s0[2] + s0[3])) + ((s1[0] + s1[1]) + (s1[2] + s1[3])) + ((s2[0] + s2[1]) + (s2[2] + s2[3])) + ((s3[0] + s3[1]) + (s3[2] + s3[3]));
        const float rstd = rsqrtf(tt * (1.0f / 1024.0f) + EPS);
        float bias = 0.f; if (r16 < 4) bias = P.b_i[layer * 4 + r16]; else if (r16 < 8) bias = P.b_f[layer * 4 + r16 - 4];
#pragma unroll
        for (int i = 0; i < 4; ++i) { const int row = 4 * kq + i; const float rr = __shfl(rstd, row); if (r16 < 8) G[(size_t)(tokb + row) * 8 + r16] = acc[i] * rr + bias; }
    }
    __syncthreads();
}

DI void ph_cloc_mfma(const Params& P, const Ctx& C, int layer) {
    const int wave = C.wave, bid = C.gw >> 3, nb = C.ngw >> 3;
    const bf16* PR = (const bf16*)(P.ws + OFF_PROJ); const float* G = (const float*)(P.ws + OFF_GATES);
    bf16* CT = (bf16*)(P.ws + OFF_CT); float* NL = (float*)(P.ws + OFF_NL); float* MLOC = NL + 8 * 64 * 128; float* BLAST = MLOC + 512;
    LAS unsigned char* imgK = C.lds + LDS_IMGK; LAS unsigned char* imgV = C.lds + LDS_IMGV; LAS float* sw = (LAS float*)(C.lds + LDS_SCAL) + 768;
    for (int unit = bid; unit < 8 * NSC; unit += nb) {
        int lane = C.lane; asm volatile("" : "+v"(lane));
        const int tid = wave * 64 + lane, r32 = lane & 31, h = lane >> 5;
        const int sc = unit & 63, bh = unit >> 6, b = bh >> 2, hh = bh & 3, tok0 = b * SEQ + sc * SC;
        __syncthreads();
        if (wave == 0) {
            float bb[4], aa[4]; gate_scalars(G, tok0, hh, lane, bb, aa);
            const float A = wave_max(fmaxf(fmaxf(aa[0], aa[1]), fmaxf(aa[2], aa[3])));
            const float blast = __shfl(bb[3], 63);
#pragma unroll
            for (int j = 0; j < 4; ++j) sw[4 * lane + j] = __expf(aa[j] - A);
            if (lane == 0) { MLOC[unit] = blast + A; BLAST[unit] = blast; }
        }
        __syncthreads();
        stage_tile_conv<true>(imgK, PR + ml_off(S_MK, b, hh, sc * SC), P.conv_w + (size_t)layer * 4096 + 512 + hh * 128, P.conv_b + layer * 1024 + 512 + hh * 128, sc == 0, tid, sw);
        stage_tile<false>(imgV, PR + ml_off(S_MV, b, hh, sc * SC), 128, tid, nullptr);
        __syncthreads();
        const int eb = wave >> 1, db0 = 2 * (wave & 1);
        f32x16 acc0 = {}, acc1 = {}, accn = {};
        bf16x8 ones; { const short o = (r32 == 0) ? (short)0x3F80 : (short)0; ones = (bf16x8){o, o, o, o, o, o, o, o}; }
#pragma unroll 4
        for (int ks = 0; ks < 16; ++ks) {
            const int rlo = 16 * ks + 8 * h, rhi = rlo + 4;
            const bf16x8 A = tr_frag(imgV, lane, eb, rlo, rhi);
            const bf16x8 B0 = tr_frag(imgK, lane, db0, rlo, rhi), B1 = tr_frag(imgK, lane, db0 + 1, rlo, rhi);
            acc0 = MFMA32(A, B0, acc0); acc1 = MFMA32(A, B1, acc1);
            if (wave < 4) { const bf16x8 Bn = tr_frag(imgK, lane, wave, rlo, rhi); accn = MFMA32(ones, Bn, accn); }
        }
        bf16* ct = CT + (size_t)unit * 16384;
#pragma unroll
        for (int i = 0; i < 16; ++i) { const int e = 32 * eb + crow(i, h);
            ct[e * 128 + 32 * db0 + r32] = (bf16)f2bf(acc0[i]); ct[e * 128 + 32 * (db0 + 1) + r32] = (bf16)f2bf(acc1[i]); }
        if (wave < 4 && h == 0) NL[(size_t)unit * 128 + 32 * wave + r32] = accn[0];
    }
}

DI void ph_scan_bf16(const Params& P, const Ctx& C) {
    unsigned* CT = (unsigned*)(P.ws + OFF_CT); float* NL = (float*)(P.ws + OFF_NL); const float* MLOC = NL + 8 * 64 * 128; const float* BLAST = MLOC + 512; float* MPREV = NL + 8 * 64 * 128 + 1024;
    const int gt = (C.gw >> 3) * 512 + C.tid, ngt = (C.ngw >> 3) * 512;
    for (int idx = gt; idx < 8 * 8192; idx += ngt) {
        const int bh = __builtin_amdgcn_readfirstlane(idx >> 13), r = idx & 8191;
        unsigned* ptr = CT + (size_t)bh * 64 * 8192 + r;
        float c0 = 0.f, c1 = 0.f, m = 0.f;
        for (int s0 = 0; s0 < NSC; s0 += 8) {
            unsigned cl[8];
#pragma unroll
            for (int i = 0; i < 8; ++i) cl[i] = ptr[(size_t)(s0 + i) * 8192];
#pragma unroll
            for (int i = 0; i < 8; ++i) {
                const float ml = MLOC[bh * 64 + s0 + i], bl = BLAST[bh * 64 + s0 + i];
                ptr[(size_t)(s0 + i) * 8192] = cvtpk(c0, c1);
                const float mn = fmaxf(bl + m, ml), sp = __expf(bl + m - mn), sl = __expf(ml - mn);
                c0 = sp * c0 + sl * bflo(cl[i]); c1 = sp * c1 + sl * bfhi(cl[i]); m = mn;
            }
        }
    }
    if (C.tid < 8) {
        for (int idx = ((C.ngw >> 3) - 1 - (C.gw >> 3)) * 8 + C.tid; idx < 8 * 128; idx += (C.ngw >> 3) * 8) {
            const int bh = __builtin_amdgcn_readfirstlane(idx >> 7), r = idx & 127;
            float* ptr = NL + (size_t)bh * 64 * 128 + r;
            float c = 0.f, m = 0.f;
            for (int s0 = 0; s0 < NSC; s0 += 16) {
                float cl[16], ml[16], bl[16];
#pragma unroll
                for (int i = 0; i < 16; ++i) { cl[i] = ptr[(s0 + i) * 128]; ml[i] = MLOC[bh * 64 + s0 + i]; bl[i] = BLAST[bh * 64 + s0 + i]; }
#pragma unroll
                for (int i = 0; i < 16; ++i) {
                    ptr[(s0 + i) * 128] = c; if (r == 0) MPREV[bh * 64 + s0 + i] = m;
                    const float mn = fmaxf(bl[i] + m, ml[i]);
                    c = __expf(bl[i] + m - mn) * c + __expf(ml[i] - mn) * cl[i]; m = mn;
                }
            }
        }
    }
}

DI void ph_mlstm_out_mfma(const Params& P, const Ctx& C, int layer) {
    const int wave = C.wave, bid = C.gw >> 3, nb = C.ngw >> 3;
    const bf16* PR = (const bf16*)(P.ws + OFF_PROJ); const float* G = (const float*)(P.ws + OFF_GATES);
    const bf16* CT = (const bf16*)(P.ws + OFF_CT); const float* NL = (const float*)(P.ws + OFF_NL); const float* MPREV = NL + 8 * 64 * 128 + 1024;
    bf16* Y = (bf16*)(P.ws + OFF_Y);
    LAS unsigned char* imgK = C.lds + LDS_IMGK; LAS unsigned char* imgV = C.lds + LDS_IMGV;
    LAS float* sa = (LAS float*)(C.lds + LDS_SCAL); LAS float* sb = sa + 256; LAS float* sM = sa + 512;
    TS_DECL;
    for (int unit = bid; unit < 8 * NSC; unit += nb) {
        TS_RESET();
        int lane = C.lane; asm volatile("" : "+v"(lane));
        const int tid = wave * 64 + lane, r32 = lane & 31, h = lane >> 5;
        const int sc = unit & 63, bh = unit >> 6, b = bh >> 2, hh = bh & 3, tok0 = b * SEQ + sc * SC;
        const float mprev = MPREV[unit];
        __syncthreads();
        if (wave == 0) {
            float bb[4], aa[4]; gate_scalars(G, tok0, hh, lane, bb, aa);
            float cm[4]; cm[0] = aa[0]; cm[1] = fmaxf(cm[0], aa[1]); cm[2] = fmaxf(cm[1], aa[2]); cm[3] = fmaxf(cm[2], aa[3]);
            const float incl = scan_max(cm[3], lane); float excl = __shfl_up(incl, 1); if (lane == 0) excl = -INFINITY;
#pragma unroll
            for (int j = 0; j < 4; ++j) { sa[4 * lane + j] = aa[j]; sb[4 * lane + j] = bb[j]; sM[4 * lane + j] = fmaxf(mprev, fmaxf(excl, cm[j])); }
        }
        stage_tile_conv<false>(imgV, PR + ml_off(S_MQ, b, hh, sc * SC), P.conv_w + (size_t)layer * 4096 + hh * 128, P.conv_b + layer * 1024 + hh * 128, sc == 0, tid, nullptr);
        { const bf16* cg = CT + (size_t)unit * 16384; v4u cv[4];
#pragma unroll
          for (int i = 0; i < 4; ++i) { const int id = tid + 512 * i; cv[i] = *(const v4u*)(cg + (size_t)id * 8); }
#pragma unroll
          for (int i = 0; i < 4; ++i) { const int id = tid + 512 * i; *(LAS v4u*)(imgK + img_off(id >> 4, id & 15)) = cv[i]; }
          if (tid < 16) { const float* np = NL + (size_t)unit * 128 + 8 * tid; const f32x4 n0 = *(const f32x4*)np, n1 = *(const f32x4*)(np + 4);
              *(LAS bf16x8*)(imgK + img_off(128, tid)) = pack8(n0.x, n0.y, n0.z, n0.w, n1.x, n1.y, n1.z, n1.w); } }
        __syncthreads();
        TS_MARK(4);
        const int qb = (wave & 1) ? 7 - (wave >> 1) : (wave >> 1), q0 = 32 * qb, tokq = tok0 + q0 + r32;
        bf16x8 qf[8];
#pragma unroll
        for (int ks = 0; ks < 8; ++ks) qf[ks] = *(const LAS bf16x8*)(imgV + img_off(q0 + r32, 2 * ks + h));
        f32x16 o0 = {}, o1 = {}, o2 = {}, o3 = {}, o4 = {};
        v4u vx[8];
        stage_tile_load(vx, PR + ml_off(S_MV, b, hh, sc * SC), 128, tid);
#pragma unroll
        for (int ks = 0; ks < 8; ++ks) {
            o0 = MFMA32(*(const LAS bf16x8*)(imgK + img_off(r32, 2 * ks + h)), qf[ks], o0);
            o1 = MFMA32(*(const LAS bf16x8*)(imgK + img_off(32 + r32, 2 * ks + h)), qf[ks], o1);
            o2 = MFMA32(*(const LAS bf16x8*)(imgK + img_off(64 + r32, 2 * ks + h)), qf[ks], o2);
            o3 = MFMA32(*(const LAS bf16x8*)(imgK + img_off(96 + r32, 2 * ks + h)), qf[ks], o3);
            const bf16x8 nrow = *(const LAS bf16x8*)(imgK + img_off(128, 2 * ks + h)); const bf16x8 zf = {};
            o4 = MFMA32(r32 == 0 ? nrow : zf, qf[ks], o4);
        }
        TS_MARK(5);
        __syncthreads();
        stage_tile_store(imgV, vx, tid);
        stage_tile_conv<false>(imgK, PR + ml_off(S_MK, b, hh, sc * SC), P.conv_w + (size_t)layer * 4096 + 512 + hh * 128, P.conv_b + layer * 1024 + 512 + hh * 128, sc == 0, tid, nullptr);
        __syncthreads();
        TS_MARK(6);
        const float Mq = sM[q0 + r32];
        float den;
        { const float si = ML_SCALE * __expf(mprev - Mq); o0 *= si; o1 *= si; o2 *= si; o3 *= si; den = __shfl(o4[0], r32) * si; }
        float dsum = 0.f;
        for (int kt = 0; kt <= qb; ++kt) {
            f32x16 s = {};
#pragma unroll
            for (int ks = 0; ks < 8; ++ks) s = MFMA32(*(const LAS bf16x8*)(imgK + img_off(32 * kt + r32, 2 * ks + h)), qf[ks], s);
            float p[16];
#pragma unroll
            for (int g = 0; g < 4; ++g) { const f32x4 a4 = *(const LAS f32x4*)(sa + 32 * kt + 8 * g + 4 * h);
#pragma unroll
                for (int j = 0; j < 4; ++j) { float v = s[4 * g + j] * (ML_SCALE * __expf(a4[j] - Mq)); if (kt == qb && (8 * g + 4 * h + j) > r32) v = 0.f; p[4 * g + j] = v; dsum += v; } }
            const bf16x8 pf0 = pack8(p[0], p[1], p[2], p[3], p[4], p[5], p[6], p[7]), pf1 = pack8(p[8], p[9], p[10], p[11], p[12], p[13], p[14], p[15]);
#pragma unroll
            for (int s2 = 0; s2 < 2; ++s2) {
                const int rlo = 32 * kt + 16 * s2 + 4 * h, rhi = rlo + 8; const bf16x8 pf = s2 ? pf1 : pf0;
                o0 = MFMA32(tr_frag(imgV, lane, 0, rlo, rhi), pf, o0);
                o1 = MFMA32(tr_frag(imgV, lane, 1, rlo, rhi), pf, o1);
                o2 = MFMA32(tr_frag(imgV, lane, 2, rlo, rhi), pf, o2);
                o3 = MFMA32(tr_frag(imgV, lane, 3, rlo, rhi), pf, o3);
            }
        }
        TS_MARK(7);
        den += dsum + __shfl_xor(dsum, 32);
        const float inv = 1.0f / fmaxf(fabsf(den), __expf(-(sb[q0 + r32] + Mq)));
        const int chk = lane & 7;
        v4u og[4][2], zg[4][2];
#pragma unroll
        for (int i = 0; i < 4; ++i) { const int trow = sc * SC + q0 + (lane >> 3) + 8 * i; const bf16* op = PR + ml_off(S_MO, b, hh, trow) + 16 * chk; const bf16* zp = PR + ml_off(S_MZ, b, hh, trow) + 16 * chk;
            og[i][0] = *(const v4u*)op; og[i][1] = *(const v4u*)(op + 8); zg[i][0] = *(const v4u*)zp; zg[i][1] = *(const v4u*)(zp + 8); }
        __syncthreads();
        LAS unsigned char* st = C.lds + wave * 16896;
#define ML_ST(OV, EB) _Pragma("unroll") for (int g = 0; g < 4; ++g) *(LAS f32x4*)(st + r32 * 528 + (32 * (EB) + 8 * g + 4 * h) * 4) = (f32x4){OV[4 * g] * inv, OV[4 * g + 1] * inv, OV[4 * g + 2] * inv, OV[4 * g + 3] * inv};
        ML_ST(o0, 0) ML_ST(o1, 1) ML_ST(o2, 2) ML_ST(o3, 3)
#undef ML_ST
        f32x4 mw4[4];
#pragma unroll
        for (int k = 0; k < 4; ++k) mw4[k] = *(const f32x4*)(P.mnorm_w + layer * 512 + hh * 128 + 16 * chk + 4 * k);
#pragma unroll
        for (int i = 0; i < 4; ++i) {
            const int row = (lane >> 3) + 8 * i;
            const v4u og0 = og[i][0], og1 = og[i][1], zg0 = zg[i][0], zg1 = zg[i][1];
            float hv[16];
#pragma unroll
            for (int k = 0; k < 4; ++k) { const f32x4 x = *(const LAS f32x4*)(st + row * 528 + chk * 64 + 16 * k); hv[4 * k] = x.x; hv[4 * k + 1] = x.y; hv[4 * k + 2] = x.z; hv[4 * k + 3] = x.w; }
            const float gq[16] = {bflo(og0.x), bfhi(og0.x), bflo(og0.y), bfhi(og0.y), bflo(og0.z), bfhi(og0.z), bflo(og0.w), bfhi(og0.w), bflo(og1.x), bfhi(og1.x), bflo(og1.y), bfhi(og1.y), bflo(og1.z), bfhi(og1.z), bflo(og1.w), bfhi(og1.w)};
            const float zq[16] = {bflo(zg0.x), bfhi(zg0.x), bflo(zg0.y), bfhi(zg0.y), bflo(zg0.z), bfhi(zg0.z), bflo(zg0.w), bfhi(zg0.w), bflo(zg1.x), bfhi(zg1.x), bflo(zg1.y), bfhi(zg1.y), bflo(zg1.z), bfhi(zg1.z), bflo(zg1.w), bfhi(zg1.w)};
            float ss = 0.f;
#pragma unroll
            for (int k = 0; k < 16; ++k) { hv[k] *= gq[k]; ss += hv[k] * hv[k]; }
            ss += __shfl_xor(ss, 1); ss += __shfl_xor(ss, 2); ss += __shfl_xor(ss, 4);
            const float rn = rsqrtf(ss * (1.f / 128.f) + EPS);
            float y[16];
#pragma unroll
            for (int k = 0; k < 16; ++k) y[k] = hv[k] * rn * mw4[k >> 2][k & 3] * zq[k];
            bf16* yp = Y + (size_t)(tok0 + q0 + row) * 1024 + hh * 128 + 16 * chk;
            v4u w0, w1; w0.x = cvtpk(y[0], y[1]); w0.y = cvtpk(y[2], y[3]); w0.z = cvtpk(y[4], y[5]); w0.w = cvtpk(y[6], y[7]); w1.x = cvtpk(y[8], y[9]); w1.y = cvtpk(y[10], y[11]); w1.z = cvtpk(y[12], y[13]); w1.w = cvtpk(y[14], y[15]);
            *(v4u*)yp = w0; *(v4u*)(yp + 8) = w1;
        }
        (void)tokq;
        if (TS_PROBE >= 70) asm volatile("s_waitcnt vmcnt(0)" ::: "memory"); TS_MARK(8);
    }
}
constexpr size_t OFF_SELP = 496 * MiB;
constexpr size_t OFF_LPART = 497 * MiB;
constexpr int LDS_MK = 0, LDS_MV = 32768, LDS_MQ = 65536, LDS_MCNT = 65536 + 16384;
constexpr float LOG2E = 1.4426950408889634f;

DI int mk_off(int row, int ch) { return 128 * row + 16 * (ch ^ ((row >> 1) & 7)); }
DI int mv_off(int row, int half) { return 128 * row + 64 * (half ^ ((row >> 1) & 1)); }
DI void moba_stage_load(v4u (&kv)[4], v4u (&vv)[4], const bf16* kg, const bf16* vg, int tid) {
#pragma unroll
    for (int i = 0; i < 4; ++i) { const int id = tid + 512 * i, row = id >> 3, ch = id & 7; kv[i] = *(const v4u*)(kg + (size_t)row * 64 + ch * 8); vv[i] = *(const v4u*)(vg + (size_t)row * 64 + ch * 8); }
}
DI void moba_stage_store(LAS unsigned char* lds, const v4u (&kv)[4], const v4u (&vv)[4], int tid) {
#pragma unroll
    for (int i = 0; i < 4; ++i) { const int id = tid + 512 * i, row = id >> 3, ch = id & 7;
        *(LAS v4u*)(lds + LDS_MK + mk_off(row, ch)) = kv[i]; *(LAS v4u*)(lds + LDS_MV + mv_off(row, ch >> 2) + 16 * (ch & 3)) = vv[i]; }
}
DI void moba_stage(LAS unsigned char* lds, const bf16* kg, const bf16* vg, int tid) {
    v4u kv[4], vv[4];
#pragma unroll
    for (int i = 0; i < 4; ++i) { const int id = tid + 512 * i, row = id >> 3, ch = id & 7; kv[i] = *(const v4u*)(kg + (size_t)row * 64 + ch * 8); vv[i] = *(const v4u*)(vg + (size_t)row * 64 + ch * 8); }
#pragma unroll
    for (int i = 0; i < 4; ++i) { const int id = tid + 512 * i, row = id >> 3, ch = id & 7;
        *(LAS v4u*)(lds + LDS_MK + mk_off(row, ch)) = kv[i]; *(LAS v4u*)(lds + LDS_MV + mv_off(row, ch >> 2) + 16 * (ch & 3)) = vv[i]; }
}
template <bool MASK> DI void moba_kb(const LAS unsigned char* lds, int kb, const bf16x8 (&qf)[4], const float (&kbias)[16], float base, int r32, int h, int blk, int q4, int p4, f32x16& o0, f32x16& o1, float& l) {
    constexpr float C2 = 0.125f * LOG2E;
    f32x16 s = {};
#pragma unroll
    for (int ks = 0; ks < 4; ++ks) s = MFMA32(*(const LAS bf16x8*)(lds + LDS_MK + mk_off(32 * kb + r32, 2 * ks + h)), qf[ks], s);
    float p[16];
#pragma unroll
    for (int i = 0; i < 16; ++i) { float v = __builtin_amdgcn_exp2f(fmaf(s[i], C2, kbias[i] + base)); if (MASK && crow(i, h) > r32) v = 0.f; p[i] = v; l += v; }
    const bf16x8 pf0 = pack8(p[0], p[1], p[2], p[3], p[4], p[5], p[6], p[7]), pf1 = pack8(p[8], p[9], p[10], p[11], p[12], p[13], p[14], p[15]);
#pragma unroll
    for (int s2 = 0; s2 < 2; ++s2) {
        const int rlo = 32 * kb + 16 * s2 + 4 * h + q4, rhi = rlo + 8; const bf16x8 pf = s2 ? pf1 : pf0;
#pragma unroll
        for (int c = 0; c < 2; ++c) {
            const s16x4 lo = tr_read(lds + LDS_MV + mv_off(rlo, c) + 32 * blk + 8 * p4), hi = tr_read(lds + LDS_MV + mv_off(rhi, c) + 32 * blk + 8 * p4);
            const bf16x8 A = __builtin_shufflevector(lo, hi, 0, 1, 2, 3, 4, 5, 6, 7);
            if (c == 0) o0 = MFMA32(A, pf, o0); else o1 = MFMA32(A, pf, o1);
        }
    }
}
template <bool DIAG> DI void moba_tile(const LAS unsigned char* lds, int lane, const bf16x8 (&qf)[4], int nkb, float slope2, float base0, f32x16& o0, f32x16& o1, float& l) {
    const int r32 = lane & 31, h = lane >> 5, blk = (lane >> 4) & 1, q4 = (lane & 15) >> 2, p4 = lane & 3;
    float kbias[16];
#pragma unroll
    for (int i = 0; i < 16; ++i) kbias[i] = slope2 * (float)crow(i, h);
    const int nfull = DIAG ? nkb - 1 : nkb;
    int kb = 0;
    float l2 = 0.f;
    for (; kb + 1 < nfull; kb += 2) {
        moba_kb<false>(lds, kb, qf, kbias, base0 + slope2 * (float)(32 * kb), r32, h, blk, q4, p4, o0, o1, l);
        moba_kb<false>(lds, kb + 1, qf, kbias, base0 + slope2 * (float)(32 * kb + 32), r32, h, blk, q4, p4, o0, o1, l2);
    }
    if (kb < nfull) { moba_kb<false>(lds, kb, qf, kbias, base0 + slope2 * (float)(32 * kb), r32, h, blk, q4, p4, o0, o1, l); ++kb; }
    if (DIAG) moba_kb<true>(lds, kb, qf, kbias, base0 + slope2 * (float)(32 * kb), r32, h, blk, q4, p4, o0, o1, l2);
    l += l2;
}
DI float moba_score_bound(const Params& P, int layer, int lane) {
    const float mq = wave_max(fabsf(P.qn_w[layer * 64 + lane])), mk = wave_max(fabsf(P.kn_w[layer * 64 + lane]));
    return __builtin_bit_cast(float, __builtin_amdgcn_readfirstlane(__builtin_bit_cast(int, 8.0f * mq * mk * LOG2E * 1.01f)));
}
DI int moba_live_dist(float b2, int hd) {
    const float slope2 = exp2f(-(float)(hd + 1)) * LOG2E;
    const float d = (150.0f + b2) / slope2;
    return d > 1.0e6f ? 1000000 : (int)d + 1;
}

#define TOP3_INS(V, N) do { const float v_ = (V); const int n_ = (N); \
    if (v_ > v0 || (v_ == v0 && n_ < i0)) { v2 = v1; i2 = i1; v1 = v0; i1 = i0; v0 = v_; i0 = n_; } \
    else if (v_ > v1 || (v_ == v1 && n_ < i1)) { v2 = v1; i2 = i1; v1 = v_; i1 = n_; } \
    else if (v_ > v2 || (v_ == v2 && n_ < i2)) { v2 = v_; i2 = n_; } } while (0)
#define TOP3_INS_ASC(V, N) do { const float v_ = (V); const int n_ = (N); const bool c0_ = v_ > v0, c1_ = v_ > v1, c2_ = v_ > v2; \
    v2 = c1_ ? v1 : (c2_ ? v_ : v2); i2 = c1_ ? i1 : (c2_ ? n_ : i2); \
    v1 = c0_ ? v0 : (c1_ ? v_ : v1); i1 = c0_ ? i0 : (c1_ ? n_ : i1); \
    v0 = c0_ ? v_ : v0; i0 = c0_ ? n_ : i0; } while (0)
DI void ph_select_mfma(const Params& P, const Ctx& C) {
    const bf16* PR = (const bf16*)(P.ws + OFF_PROJ); const float* KM = (const float*)(P.ws + OFF_KMEAN); unsigned* SELP = (unsigned*)(P.ws + OFF_SELP);
    const int wave = C.wave, bid = C.gw >> 3, nb = C.ngw >> 3;
    const int bh = bid & 15, b = bh >> 3, hd = bh & 7, m = bid >> 4, nm = (nb + 15 - bh) >> 4;
    __syncthreads();
    { const int tid = wave * 64 + C.lane, row = tid >> 3, ch = tid & 7;
      const float* kp = KM + ((size_t)bh * 64 + row) * 128 + 8 * ch;
      const f32x4 a = (*(const f32x4*)kp + *(const f32x4*)(kp + 64)) * (1.f / 256.f), c = (*(const f32x4*)(kp + 4) + *(const f32x4*)(kp + 68)) * (1.f / 256.f);
      v4u hi; hi.x = cvtpk(a.x, a.y); hi.y = cvtpk(a.z, a.w); hi.z = cvtpk(c.x, c.y); hi.w = cvtpk(c.z, c.w);
      v4u lo; lo.x = cvtpk(a.x - bflo(hi.x), a.y - bfhi(hi.x)); lo.y = cvtpk(a.z - bflo(hi.y), a.w - bfhi(hi.y)); lo.z = cvtpk(c.x - bflo(hi.z), c.y - bfhi(hi.z)); lo.w = cvtpk(c.z - bflo(hi.w), c.w - bfhi(hi.w));
      *(LAS v4u*)(C.lds + mk_off(row, ch)) = hi; *(LAS v4u*)(C.lds + 8192 + mk_off(row, ch)) = lo; }
    __syncthreads();
    for (int qt = m + nm * wave; qt < 512; qt += nm * 8) {
        int lane = C.lane; asm volatile("" : "+v"(lane));
        const int r32 = lane & 31, h = lane >> 5;
        const int t0 = 32 * qt, j = t0 >> 8;
        unsigned* out = SELP + (size_t)bh * SEQ + t0 + r32;
        if (j == 0) { if (h == 0) *out = 0x00FFFFFFu; continue; }
        bf16x8 qf[4];
#pragma unroll
        for (int ks = 0; ks < 4; ++ks) qf[ks] = *(const bf16x8*)(PR + at_off(S_AQ, b, hd, t0 + r32) + 16 * ks + 8 * h);
        float v0 = -INFINITY, v1 = -INFINITY, v2 = -INFINITY; int i0 = 255, i1 = 255, i2 = 255;
        const int nbk = j > 32 ? 2 : 1;
        for (int nbi = 0; nbi < nbk; ++nbi) {
            f32x16 acc = {};
#pragma unroll
            for (int ks = 0; ks < 4; ++ks) {
                const bf16x8 hi = *(const LAS bf16x8*)(C.lds + mk_off(32 * nbi + r32, 2 * ks + h)), lo = *(const LAS bf16x8*)(C.lds + 8192 + mk_off(32 * nbi + r32, 2 * ks + h));
                acc = MFMA32(hi, qf[ks], acc); acc = MFMA32(lo, qf[ks], acc);
            }
#pragma unroll
            for (int i = 0; i < 16; ++i) { const int n = 32 * nbi + crow(i, h); const float x = n < j ? acc[i] : -INFINITY; TOP3_INS_ASC(x, n); }
        }
        const float w0 = __shfl_xor(v0, 32), w1 = __shfl_xor(v1, 32), w2 = __shfl_xor(v2, 32); const int k0 = __shfl_xor(i0, 32), k1 = __shfl_xor(i1, 32), k2 = __shfl_xor(i2, 32);
        if (k0 != 255) TOP3_INS(w0, k0);
        if (k1 != 255) TOP3_INS(w1, k1);
        if (k2 != 255) TOP3_INS(w2, k2);
        if (h == 0) *out = (unsigned)i0 | ((unsigned)i1 << 8) | ((unsigned)i2 << 16);
    }
}

constexpr int CW_WQ = 8192;
constexpr int LDS_MQ2 = 65536, LDS_MSCR = 98304, LDS_MCTL = 136192;
DI void ph_moba_sel_mfma(const Params& P, const Ctx& C, int layer) {
    const int wave = C.wave;
    const bf16* PR = (const bf16*)(P.ws + OFF_PROJ); bf16* Y = (bf16*)(P.ws + OFF_Y); bf16* XNB = (bf16*)P.out;     const unsigned* SELP = (const unsigned*)(P.ws + OFF_SELP); float* LP = (float*)(P.ws + OFF_LPART);
    unsigned* head = (unsigned*)(P.ws + OFF_CTL) + CW_WQ + 64 * layer;
    LAS unsigned short* queue = (LAS unsigned short*)(C.lds + LDS_MQ2); LAS unsigned* ctl = (LAS unsigned*)(C.lds + LDS_MCTL);
    const float b2s = moba_score_bound(P, layer, C.lane);
    for (;;) {
        int lane = C.lane; asm volatile("" : "+v"(lane));
        const int tid = wave * 64 + lane, r32 = lane & 31, h = lane >> 5;
        __syncthreads();
        if (tid == 0) { ctl[1] = __hip_atomic_fetch_add(head, 1u, __ATOMIC_RELAXED, __HIP_MEMORY_SCOPE_AGENT); ctl[0] = 0u; }
        __syncthreads();
        const int it = (int)ctl[1];
        if (it >= 16 * 63) break;
        const int bh = it & 15, b = bh >> 3, hd = bh & 7, n = it >> 4;
        const int lim = moba_live_dist(b2s, hd);
        int t_end = 256 * n + 256 + lim; t_end = t_end > SEQ ? SEQ : ((t_end + 63) & ~63);
        const unsigned* sp = SELP + (size_t)bh * SEQ;
        { unsigned long long slots = 0ull; unsigned cnt = 0u; const int tw0 = 256 * (n + 1) + 64 * wave + lane;
          for (int c0 = 0; tw0 + 512 * c0 < t_end; c0 += 8) {
              unsigned selv[8];
#pragma unroll
              for (int u = 0; u < 8; ++u) { const int t = tw0 + 512 * (c0 + u); selv[u] = t < t_end ? sp[t] : 0x00FFFFFFu; }
#pragma unroll
              for (int u = 0; u < 8; ++u) { const int t = tw0 + 512 * (c0 + u); const unsigned sel = selv[u];
                  unsigned sl = ((sel & 0xFFu) == (unsigned)n) ? 1u : (((sel >> 8) & 0xFFu) == (unsigned)n) ? 2u : (((sel >> 16) & 0xFFu) == (unsigned)n) ? 3u : 0u;
                  if (t >= t_end || t - 256 * n - 255 > lim) sl = 0u;
                  slots |= (unsigned long long)sl << (2 * (c0 + u)); cnt += (unsigned)__popcll(__ballot(sl != 0u)); }
          }
          if (cnt) {
              unsigned base = 0; if (lane == 0) base = __hip_atomic_fetch_add(ctl, cnt, __ATOMIC_RELAXED, __HIP_MEMORY_SCOPE_WORKGROUP);
              base = __shfl(base, 0);
              for (int c = 0; tw0 + 512 * c < t_end; ++c) { const unsigned sl = (unsigned)(slots >> (2 * c)) & 3u; const unsigned long long mask = __ballot(sl != 0u);
                  if (sl) queue[base + __popcll(mask & ((1ull << lane) - 1ull))] = (unsigned short)((unsigned)(tw0 + 512 * c) | ((sl - 1u) << 14));
                  base += (unsigned)__popcll(mask); }
          } }
        __syncthreads();
        if (ctl[0] == 0u) continue;
        moba_stage(C.lds, PR + at_off(S_AK, b, hd, n * 256), PR + at_off(S_AV, b, hd, n * 256), tid);
        __syncthreads();
        const int total = (int)ctl[0], ntiles = (total + 31) >> 5;
        const float slope2 = exp2f(-(float)(hd + 1)) * LOG2E;
        int tile = wave; unsigned e = 0; bf16x8 qf[4] = {};
        if (tile < ntiles) { const int idx = tile * 32 + r32; e = queue[idx < total ? idx : 0]; const int tq = e & 0x3FFF;
#pragma unroll
            for (int ks = 0; ks < 4; ++ks) qf[ks] = *(const bf16x8*)(PR + at_off(S_AQ, b, hd, tq) + 16 * ks + 8 * h); }
        while (tile < ntiles) {
            const int nxt = tile + 8; unsigned en = 0; bf16x8 qn[4] = {};
            if (nxt < ntiles) { const int idx = nxt * 32 + r32; en = queue[idx < total ? idx : 0]; const int tqn = en & 0x3FFF;
#pragma unroll
                for (int ks = 0; ks < 4; ++ks) qn[ks] = *(const bf16x8*)(PR + at_off(S_AQ, b, hd, tqn) + 16 * ks + 8 * h); }
            const bool valid = tile * 32 + r32 < total; const int t = e & 0x3FFF, slot = e >> 14; const size_t tok = (size_t)b * SEQ + t;
            f32x16 o0 = {}, o1 = {}; float l = 0.f;
            moba_tile<false>(C.lds, lane, qf, 8, slope2, slope2 * (float)(n * 256 - t), o0, o1, l);
            l += __shfl_xor(l, 32);
            (void)valid; (void)slot; (void)tok;
            { LAS unsigned char* st = C.lds + LDS_MSCR + wave * 4608;
#pragma unroll
              for (int g = 0; g < 4; ++g) { u32x2 w; w.x = cvtpk(o0[4 * g], o0[4 * g + 1]); w.y = cvtpk(o0[4 * g + 2], o0[4 * g + 3]); *(LAS u32x2*)(st + r32 * 144 + (8 * g + 4 * h) * 2) = w;
                  w.x = cvtpk(o1[4 * g], o1[4 * g + 1]); w.y = cvtpk(o1[4 * g + 2], o1[4 * g + 3]); *(LAS u32x2*)(st + r32 * 144 + (32 + 8 * g + 4 * h) * 2) = w; }
#pragma unroll
              for (int i = 0; i < 4; ++i) { const int row = (lane >> 3) + 8 * i, chk = lane & 7, idx = tile * 32 + row;
                  const v4u w = *(const LAS v4u*)(st + row * 144 + chk * 16);
                  const float lr = __shfl(l, row);
                  if (idx < total) { const unsigned er = queue[idx]; const int tr = er & 0x3FFF, sr = er >> 14; const size_t tokr = (size_t)b * SEQ + tr;
                      bf16* dst = (sr < 2) ? XNB + tokr * 1024 + (sr * 8 + hd) * 64 : Y + tokr * 1024 + 512 + hd * 64;
                      *(v4u*)(dst + chk * 8) = w;
                      if (chk == 0) LP[(tokr * 8 + hd) * 4 + sr] = lr; } } }
            tile = nxt; e = en;
#pragma unroll
            for (int ks = 0; ks < 4; ++ks) qf[ks] = qn[ks];
        }
    }
}

DI void ph_moba_own_mfma(const Params& P, const Ctx& C, int layer) {
    const int wave = C.wave, bid = C.gw >> 3, nb = C.ngw >> 3;
    const bf16* PR = (const bf16*)(P.ws + OFF_PROJ); bf16* Y = (bf16*)(P.ws + OFF_Y); const float* LP = (const float*)(P.ws + OFF_LPART);
    const int i0 = bid, i1 = 16 * NBLK, istep = nb;
    TS_DECL;
    v4u pk[4], pv[4];
    if (i0 < i1) { const int bh = ((i0 & 15) + 5 * (i0 >> 8)) & 15; moba_stage_load(pk, pv, PR + at_off(S_AK, bh >> 3, bh & 7, (i0 >> 4) * 256), PR + at_off(S_AV, bh >> 3, bh & 7, (i0 >> 4) * 256), wave * 64 + C.lane); }
    const float b2s = moba_score_bound(P, layer, C.lane);
    for (int it = i0; it < i1; it += istep) {
        int lane = C.lane; asm volatile("" : "+v"(lane));
        const int tid = wave * 64 + lane, r32 = lane & 31, h = lane >> 5;
        const int bh = ((it & 15) + 5 * (it >> 8)) & 15, b = bh >> 3, hd = bh & 7, j = it >> 4;
        TS_RESET();
        __syncthreads();
        moba_stage_store(C.lds, pk, pv, tid);
        __syncthreads();
        TS_MARK(0);
        if (it + istep < i1) { const int itn = it + istep, bhn = ((itn & 15) + 5 * (itn >> 8)) & 15; moba_stage_load(pk, pv, PR + at_off(S_AK, bhn >> 3, bhn & 7, (itn >> 4) * 256), PR + at_off(S_AV, bhn >> 3, bhn & 7, (itn >> 4) * 256), tid); }
        const int qb = (wave & 1) ? 7 - (wave >> 1) : (wave >> 1), tl = 32 * qb + r32;
        bf16x8 qf[4];
#pragma unroll
        for (int ks = 0; ks < 4; ++ks) qf[ks] = *(const bf16x8*)(PR + at_off(S_AQ, b, hd, j * 256 + tl) + 16 * ks + 8 * h);
        const float slope2 = exp2f(-(float)(hd + 1)) * LOG2E;
        f32x16 o0 = {}, o1 = {}; float l = 0.f;
        moba_tile<true>(C.lds, lane, qf, qb + 1, slope2, -slope2 * (float)tl, o0, o1, l);
        l += __shfl_xor(l, 32);
        TS_MARK(1);
        const int lim = moba_live_dist(b2s, hd);
        LAS unsigned char* st = C.lds + 65536 + wave * 9216;
#pragma unroll
        for (int g = 0; g < 4; ++g) { *(LAS f32x4*)(st + r32 * 272 + (8 * g + 4 * h) * 4) = (f32x4){o0[4 * g], o0[4 * g + 1], o0[4 * g + 2], o0[4 * g + 3]};
            *(LAS f32x4*)(st + r32 * 272 + (32 + 8 * g + 4 * h) * 4) = (f32x4){o1[4 * g], o1[4 * g + 1], o1[4 * g + 2], o1[4 * g + 3]}; }
        const unsigned* selp = (const unsigned*)(P.ws + OFF_SELP) + (size_t)bh * SEQ + j * 256 + 32 * qb;
#pragma unroll
        for (int i = 0; i < 4; ++i) {
            const int row = (lane >> 3) + 8 * i, chk = lane & 7, tpos = j * 256 + 32 * qb + row; const size_t tokr = (size_t)b * SEQ + tpos;
            const f32x4 a = *(const LAS f32x4*)(st + row * 272 + chk * 32), c = *(const LAS f32x4*)(st + row * 272 + chk * 32 + 16);
            float v[8] = {a.x, a.y, a.z, a.w, c.x, c.y, c.z, c.w};
            float lr = __shfl(l, row);
            const unsigned sel = selp[row]; const int n0 = sel & 0xFF, n1 = (sel >> 8) & 0xFF, n2 = (sel >> 16) & 0xFF;
            const bool live0 = n0 != 255 && tpos - 256 * n0 - 255 <= lim, live1 = n1 != 255 && tpos - 256 * n1 - 255 <= lim, live2 = n2 != 255 && tpos - 256 * n2 - 255 <= lim;
            const f32x4 lp = *(const f32x4*)(LP + (tokr * 8 + hd) * 4);
            const bf16* p0 = (const bf16*)P.out + tokr * 1024 + hd * 64 + chk * 8; bf16* yp = Y + tokr * 1024 + 512 + hd * 64 + chk * 8;
#define ADD8(W) do { v[0] += bflo((W).x); v[1] += bfhi((W).x); v[2] += bflo((W).y); v[3] += bfhi((W).y); v[4] += bflo((W).z); v[5] += bfhi((W).z); v[6] += bflo((W).w); v[7] += bfhi((W).w); } while (0)
            const bf16* zp = PR + at_off(S_AZ, b, hd, tpos) + chk * 8;
            const v4u w0 = *(const v4u*)(live0 ? p0 : zp), w1 = *(const v4u*)(live1 ? p0 + 512 : zp), w2 = *(const v4u*)(live2 ? (const bf16*)yp : zp);
            const v4u z = *(const v4u*)zp; const v4u zero4 = {0u, 0u, 0u, 0u};
            { const v4u w = live0 ? w0 : zero4; ADD8(w); lr += live0 ? lp.x : 0.f; }
            { const v4u w = live1 ? w1 : zero4; ADD8(w); lr += live1 ? lp.y : 0.f; }
            { const v4u w = live2 ? w2 : zero4; ADD8(w); lr += live2 ? lp.z : 0.f; }
#undef ADD8
            const float inv = 1.0f / lr;
            v4u y; y.x = cvtpk(v[0] * inv * bflo(z.x), v[1] * inv * bfhi(z.x)); y.y = cvtpk(v[2] * inv * bflo(z.y), v[3] * inv * bfhi(z.y));
            y.z = cvtpk(v[4] * inv * bflo(z.z), v[5] * inv * bfhi(z.z)); y.w = cvtpk(v[6] * inv * bflo(z.w), v[7] * inv * bfhi(z.w));
            *(v4u*)yp = y;
        }
        if (TS_PROBE >= 70) asm volatile("s_waitcnt vmcnt(0)" ::: "memory"); TS_MARK(2);
    }
}
typedef const __attribute__((address_space(4))) Params* KargPtr;
constexpr int CW_TS = 16384;

DI int mk_lane() { return (int)__builtin_amdgcn_mbcnt_hi(~0u, __builtin_amdgcn_mbcnt_lo(~0u, 0u)); }
template <int LAYER, int PH> DI void run_phase(LAS unsigned char* lds0, int wave_s) {
    KargPtr pk = (KargPtr)__builtin_amdgcn_kernarg_segment_ptr(); asm volatile("" : "+s"(pk));
    Params P; P.x = pk->x; P.norm_w = pk->norm_w; P.w_in = pk->w_in; P.b_i = pk->b_i; P.b_f = pk->b_f; P.conv_w = pk->conv_w; P.conv_b = pk->conv_b;
    P.mnorm_w = pk->mnorm_w; P.qn_w = pk->qn_w; P.kn_w = pk->kn_w; P.w_out = pk->w_out; P.out = pk->out; P.ws = pk->ws; P.ph_lo = 0; P.ph_hi = 0;
    int tid_ = wave_s * 64 + mk_lane(); asm volatile("" : "+v"(tid_));
    Ctx C; C.lds = lds0; C.tid = tid_; C.lane = tid_ & 63; C.wave = wave_s;
    int bid_ = blockIdx.x, gdim_ = gridDim.x; asm volatile("" : "+s"(bid_), "+s"(gdim_));
    C.gw = bid_ * 8 + C.wave; C.ngw = gdim_ * 8;
    constexpr int layer = LAYER;
#ifndef DUP_MASK
#define DUP_MASK 0
#endif
#define DUPN(bit) (((DUP_MASK) >> (bit)) & 1 ? 2 : 1)
    if constexpr (PH == -1) { for (int rep = 0; rep < DUPN(15); ++rep) { ph_prologue(P, C); __syncthreads(); } }
    else if constexpr (PH == 0) {
        pg8::Gemm g{(const pg8::bf16_t*)(P.ws + OFF_XN), (const pg8::bf16_t*)(P.ws + OFF_WIN) + (size_t)layer * PW * DM, NTOK, PW, DM};
        pg8::StaticOrder S; S.init(NTOK, PW, gdim_, bid_);
        const unsigned long long acts = (1ull << 12) | (1ull << 14) | (2ull << 16) | (2ull << 18) | (3ull << 20) | (3ull << 22) | (3ull << 24) | (3ull << 26) | (2ull << 32) | (2ull << 34);
        pg8::EpiProj E{(pg8::bf16_t*)(P.ws + OFF_PROJ), 14, acts, P.qn_w + layer * 64, P.kn_w + layer * 64, (float*)(P.ws + OFF_KMEAN), (const float*)(P.ws + OFF_SSQ)};
        for (int rep = 0; rep < DUPN(1); ++rep) pg8::gemm_phase<pg8::EpiProj, pg8::StaticOrder, true, true>(C.lds, g, S, E, C.tid);
        ph_gates_mfma(P, C, layer);
    }
    else if constexpr (PH == 1) { ph_cloc_mfma(P, C, layer); ph_select_mfma(P, C); }
    else if constexpr (PH == 2) { ph_scan_bf16(P, C); ph_moba_sel_mfma(P, C, layer); }
    else if constexpr (PH == 3) {
        const int par = bid_ & 1;
#pragma unroll 1
        for (int s_ = 0; s_ < 2; ++s_) { if ((s_ ^ par) == 0) ph_mlstm_out_mfma(P, C, layer); else ph_moba_own_mfma(P, C, layer); }
    }
    else {
        pg8::Gemm g{(const pg8::bf16_t*)(P.ws + OFF_Y), (const pg8::bf16_t*)(P.ws + OFF_WOUT) + (size_t)layer * DM * DM, NTOK, DM, DM};
        pg8::StaticOrder S; S.init(NTOK, DM, gdim_, bid_);
        pg8::EpiRes E{(pg8::bf16_t*)(P.ws + OFF_XN), P.out, (float*)(P.ws + OFF_SSQ), DM, layer == NLAYER - 1 ? 1 : 0, 1.0f};
        pg8::gemm_phase<pg8::EpiRes, pg8::StaticOrder, true, true>(C.lds, g, S, E, C.tid);
        if (DUPN(7) > 1) { __syncthreads(); pg8::EpiRes E2{(pg8::bf16_t*)(P.ws + OFF_XN), P.out, (float*)(P.ws + OFF_SSQ), DM, layer == NLAYER - 1 ? 1 : 0, 0.0f}; pg8::gemm_phase<pg8::EpiRes, pg8::StaticOrder, true, true>(C.lds, g, S, E2, C.tid); }
    }
}
DI void grid_bar(LAS unsigned char* lds0, int wave_s) {
    KargPtr pb = (KargPtr)__builtin_amdgcn_kernarg_segment_ptr(); asm volatile("" : "+s"(pb));
    XcdBarrier bar; bar.bar = (unsigned*)(pb->ws + OFF_CTL) + CW_BAR; bar.x = xb_xcc_id(); bar.st = (volatile LAS unsigned*)(lds0 + MISC_OFF) + 8;
    xcd_barrier(bar, wave_s == 0 && mk_lane() == 0);
}
DI void ts_stamp(int gp, int wave_s) {
    if (TS_PROBE >= 0 && blockIdx.x == 0 && wave_s == 0 && mk_lane() == 0) {
        KargPtr pb = (KargPtr)__builtin_amdgcn_kernarg_segment_ptr();
        ((unsigned long long*)((unsigned*)(pb->ws + OFF_CTL) + CW_TS))[gp] = __builtin_amdgcn_s_memrealtime();
    }
}
#define RUN(GP, LAYER, PH) do { if (lo <= (GP) && (GP) < hi) { ts_stamp(GP, wave_s); run_phase<LAYER, PH>(lds0, wave_s); if (TS_PROBE >= 80) { __syncthreads(); ts_stamp(64 + (GP), wave_s); } if ((GP) + 1 < hi || TS_PROBE >= 0) { grid_bar(lds0, wave_s); if (DUPN(8) > 1) grid_bar(lds0, wave_s); } } } while (0)
#define RUN_LAYER(L) RUN(1 + 5 * (L) + 0, L, 0); RUN(1 + 5 * (L) + 1, L, 1); RUN(1 + 5 * (L) + 2, L, 2); RUN(1 + 5 * (L) + 3, L, 3); RUN(1 + 5 * (L) + 4, L, 4)
__global__ void __launch_bounds__(512, 2) fwd_kernel(Params P_karg) {
    extern __shared__ __attribute__((aligned(16))) unsigned char lds_raw[];
    LAS unsigned char* const lds0 = (LAS unsigned char*)lds_raw;
    const int wave_s = __builtin_amdgcn_readfirstlane((int)threadIdx.x >> 6);
    asm volatile("s_nop 0\n s_nop 0\n s_nop 0\n s_nop 0\n s_nop 0\n s_nop 0\n s_nop 0\n s_nop 0\n s_nop 0\n s_nop 0\n s_nop 0");
    if (wave_s == 0) ((LAS unsigned*)(lds0 + MISC_OFF))[mk_lane()] = 0u;
    __syncthreads();
    int lo, hi;
    { KargPtr pk = (KargPtr)__builtin_amdgcn_kernarg_segment_ptr(); lo = pk->ph_lo; hi = pk->ph_hi;
      if (hi - lo > 1) (void)xcd_barrier_post((unsigned*)(pk->ws + OFF_CTL) + CW_BAR, (volatile LAS unsigned*)(lds0 + MISC_OFF) + 8, wave_s == 0 && mk_lane() == 0); }
    RUN(0, 0, -1);
    RUN_LAYER(0); RUN_LAYER(1); RUN_LAYER(2); RUN_LAYER(3);
    if (TS_PROBE >= 0) {
        ts_stamp(NGP, wave_s);
        grid_bar(lds0, wave_s);
        KargPtr pk = (KargPtr)__builtin_amdgcn_kernarg_segment_ptr();
        const unsigned long long* ts = (const unsigned long long*)((const unsigned*)(pk->ws + OFF_CTL) + CW_TS);
        float t_us = 400.f;
        if (TS_PROBE >= 80 && TS_PROBE < 90) { unsigned long long sum = 0; for (int l = 0; l < NLAYER; ++l) sum += ts[1 + NPH * l + (TS_PROBE - 80) + 1] - ts[64 + 1 + NPH * l + (TS_PROBE - 80)]; t_us = (float)sum * 0.01f; }
        else if (TS_PROBE >= 70 && TS_PROBE < 90) { t_us = (float)(((const unsigned*)(pk->ws + OFF_CTL) + CW_TS + 256)[TS_PROBE - 70]) * 0.01f; }
        else if (TS_PROBE < 90) { unsigned long long sum = 0; if (TS_PROBE == 50) sum = ts[1] - ts[0];
            else for (int l = 0; l < NLAYER; ++l) sum += ts[1 + NPH * l + TS_PROBE + 1] - ts[1 + NPH * l + TS_PROBE]; t_us = (float)sum * 0.01f; }
        const float a = 0.05f * sqrtf(t_us * 0.01f * TS_SCALE);
        const int gt = blockIdx.x * 512 + wave_s * 64 + mk_lane();
        for (int i = gt; i < (1 << 20); i += gridDim.x * 512) pk->out[(size_t)i * 32] += a;
    }
}

#ifndef ONE_LAUNCH
#define ONE_LAUNCH 1
#endif
extern "C" void kernel_launch(void* const* d_in, const int* in_sizes, int n_in, void* d_out, int out_size, void* d_ws, size_t ws_size, hipStream_t stream) {
    static int grid = 0;
    if (grid == 0) {
        if (n_in != 11 || in_sizes[0] != NTOK * DM || out_size != NTOK * DM || ws_size < WS_END) { fprintf(stderr, "kernel_launch: unexpected shapes (n_in %d, in0 %d, out %d, ws %zu)\n", n_in, n_in > 0 ? in_sizes[0] : -1, out_size, ws_size); grid = -1; return; }
        int dev = 0, cus = 0, per_cu = 0;
        if (hipGetDevice(&dev) != hipSuccess || hipDeviceGetAttribute(&cus, hipDeviceAttributeMultiprocessorCount, dev) != hipSuccess) { grid = -1; return; }
        if (hipFuncSetAttribute((const void*)fwd_kernel, hipFuncAttributeMaxDynamicSharedMemorySize, LDS_BYTES) != hipSuccess) { fprintf(stderr, "kernel_launch: hipFuncSetAttribute failed\n"); grid = -1; return; }
        if (hipOccupancyMaxActiveBlocksPerMultiprocessor(&per_cu, (const void*)fwd_kernel, 512, LDS_BYTES) != hipSuccess || per_cu < 1) { fprintf(stderr, "kernel_launch: occupancy query says %d blocks per CU\n", per_cu); per_cu = 1; }
        (void)hipGetLastError();
        grid = cus;
    }
    if (grid < 0) return;
    (void)hipMemsetAsync((char*)d_ws + OFF_CTL, 0, CTL_BYTES, stream);
    Params p{};
    p.x = (const float*)d_in[0]; p.norm_w = (const float*)d_in[1]; p.w_in = (const float*)d_in[2]; p.b_i = (const float*)d_in[3]; p.b_f = (const float*)d_in[4];
    p.conv_w = (const float*)d_in[5]; p.conv_b = (const float*)d_in[6]; p.mnorm_w = (const float*)d_in[7]; p.qn_w = (const float*)d_in[8]; p.kn_w = (const float*)d_in[9]; p.w_out = (const float*)d_in[10];
    p.out = (float*)d_out; p.ws = (unsigned char*)d_ws;
#if ONE_LAUNCH
    p.ph_lo = 0; p.ph_hi = NGP;
    hipLaunchKernelGGL(fwd_kernel, dim3(grid), dim3(512), LDS_BYTES, stream, p);
#else
    for (int gp = 0; gp < NGP; ++gp) { p.ph_lo = gp; p.ph_hi = gp + 1; hipLaunchKernelGGL(fwd_kernel, dim3(grid), dim3(512), LDS_BYTES, stream, p); }
#endif
}
```
